# Optimizing an MI355X kernel written in HIP

```python
import math
import jax
import jax.numpy as jnp
from jax import lax
import numpy as np

D_MODEL = 2048
BATCH = 8
SEQ = 2048
DEPTH = 2

CTX_LEN = 256
GRID_W = 64
EPS = 1e-6
ROPE_BASE = 10000.0
Q_BLOCK = 128
N_BRANCH = 4
BRANCH_W = 512

DA_HEADS = 4
DA_HEAD = 64
DA_V = 2 * DA_HEAD
RT_HEADS = 4
RT_DK = 128
RT_DV = 128
RT_CHUNK = 128
NA_HEADS = 8
NA_HEAD = 64
NA_KH = 8
NA_KW = 16
MLA_HEADS = 4
MLA_Q_LORA = 512
MLA_KV_LORA = 256
MLA_NOPE = 128
MLA_ROPE = 64
MLA_V = 128
PEER_HEADS = 8
PEER_NKEYS = 128
PEER_EXPERTS = PEER_NKEYS * PEER_NKEYS
PEER_DQ = 256
PEER_TOPK = 16
PEER_BLOCK = 128

IN_SPLITS = (
    DA_HEADS * 2 * DA_HEAD, DA_HEADS * 2 * DA_HEAD, DA_HEADS * DA_V,
    RT_HEADS * RT_DK, RT_HEADS * RT_DK, RT_HEADS * RT_DV, RT_HEADS * RT_DV,
    NA_HEADS * NA_HEAD, NA_HEADS * NA_HEAD, NA_HEADS * NA_HEAD,
    MLA_Q_LORA, MLA_KV_LORA, MLA_ROPE)
IN_WIDTH = sum(IN_SPLITS)

kernel_name = 'hybrid_diffusion_gated_block'


def _rms(x, g):
    xf = x.astype(jnp.float32)
    y = xf * lax.rsqrt(jnp.mean(xf * xf, axis=-1, keepdims=True) + EPS)
    return (y * g.astype(jnp.float32)).astype(x.dtype)


def _modulate(x, g, shift, scale):
    return _rms(x, g) * (1 + scale) + shift


def _split_in(p):
    offs = np.cumsum(np.array(IN_SPLITS))[:-1].tolist()
    return jnp.split(p, offs, axis=-1)


def _rope_tables(n_tok, dim):
    m = dim // 2
    inv = ROPE_BASE ** (-jnp.arange(0, m, 2, dtype=jnp.float32) / m)
    t = jnp.arange(n_tok)
    row = (t // GRID_W).astype(jnp.float32)
    col = (t % GRID_W).astype(jnp.float32)
    ar = row[:, None] * inv
    ac = col[:, None] * inv
    ang = jnp.concatenate([ar, ar, ac, ac], axis=-1)
    return jnp.cos(ang), jnp.sin(ang)


def _rope(x, cos, sin):
    shape = (x.shape[1],) + (1,) * (x.ndim - 3) + (x.shape[-1],)
    a, b, c, d = jnp.split(x, 4, axis=-1)
    rot = jnp.concatenate([-b, a, -d, c], axis=-1)
    return (x * cos.reshape(shape) + rot * sin.reshape(shape)).astype(x.dtype)


def _attn(q, k, v, scale):
    s = jnp.einsum('bhqd,bhkd->bhqk', q, k).astype(jnp.float32) * scale
    p = jax.nn.softmax(s, axis=-1)
    return jnp.einsum('bhqk,bhkd->bhqd', p.astype(v.dtype), v)


def _map_query_blocks(fn, q, axis):
    n = q.shape[axis]
    nb = n // Q_BLOCK
    qb = q.reshape(q.shape[:axis] + (nb, Q_BLOCK) + q.shape[axis + 1:])
    out = lax.map(fn, jnp.moveaxis(qb, axis, 0))
    out = jnp.moveaxis(out, 0, -3)
    return out.reshape(out.shape[:-3] + (n, out.shape[-1]))


def _diff_heads(q, k, v, qk_g, rope):
    B, T, _ = q.shape
    q = _rms(q.reshape(B, T, DA_HEADS, 2, DA_HEAD), qk_g[0])
    k = _rms(k.reshape(B, T, DA_HEADS, 2, DA_HEAD), qk_g[1])
    if rope is not None:
        q = _rope(q, *rope)
        k = _rope(k, *rope)
    v = v.reshape(B, T, DA_HEADS, DA_V)
    return q.transpose(0, 2, 3, 1, 4), k.transpose(0, 2, 3, 1, 4), v.transpose(0, 2, 1, 3)


def _diff_core(q, k, v, lam):
    s = jnp.einsum('bhnqd,bhnkd->bhnqk', q, k).astype(jnp.float32) * (DA_HEAD ** -0.5)
    p = jax.nn.softmax(s, axis=-1)
    a = p[:, :, 0] - lam * p[:, :, 1]
    return jnp.einsum('bhqk,bhkd->bhqd', a.astype(v.dtype), v)


def _mix_diff(ql, kl, vl, qc, kc, vc, lam_vec, qk_g, sub_g, lam_init, rope, ctx_out):
    lv = lam_vec.astype(jnp.float32)
    lam = jnp.exp(jnp.sum(lv[0] * lv[1])) - jnp.exp(jnp.sum(lv[2] * lv[3])) + lam_init
    Ql, Kl, Vl = _diff_heads(ql, kl, vl, qk_g, rope)
    Qc, Kc, Vc = _diff_heads(qc, kc, vc, qk_g, None)
    K = jnp.concatenate([Kc, Kl], axis=3)
    V = jnp.concatenate([Vc, Vl], axis=2)
    yl = _map_query_blocks(lambda qb: _diff_core(qb, K, V, lam), Ql, axis=3)

    def post(y):
        B, H, T, dv = y.shape
        y = _rms(y, sub_g) * (1.0 - lam_init)
        return y.transpose(0, 2, 1, 3).reshape(B, T, H * dv)

    yc = post(_diff_core(Qc, Kc, Vc, lam)) if ctx_out else None
    return post(yl), yc


def _retention_scan(q, k, v, log_g, state0):
    C = RT_CHUNK
    B, H, T, _ = q.shape
    nc = T // C
    n = jnp.arange(C, dtype=jnp.float32)
    diff = n[:, None] - n[None, :]
    dmat = jnp.where(diff >= 0, jnp.exp(log_g[:, None, None] * jnp.maximum(diff, 0.0)), 0.0)
    xi = jnp.exp(log_g[:, None] * (n + 1.0))
    zeta = jnp.exp(log_g[:, None] * (C - 1.0 - n))
    g_c = jnp.exp(log_g * C)

    def chunks(a):
        return jnp.moveaxis(a.reshape(B, H, nc, C, a.shape[-1]), 2, 0)

    def step(R, xs):
        qc, kc, vc = xs
        inner = jnp.einsum('bhnm,bhme->bhne', jnp.einsum('bhnd,bhmd->bhnm', qc, kc) * dmat, vc)
        cross = jnp.einsum('bhnd,bhde->bhne', qc, R) * xi[..., None]
        R = g_c[:, None, None] * R + jnp.einsum('bhmd,bhme->bhde', kc * zeta[..., None], vc)
        return R, inner + cross

    R, out = lax.scan(step, state0, (chunks(q), chunks(k), chunks(v)))
    out = jnp.moveaxis(out, 0, 2).reshape(B, H, T, v.shape[-1])
    return out, R


def _retention_state(k, v, log_g):
    L = k.shape[2]
    m = jnp.arange(L, dtype=jnp.float32)
    w = jnp.exp(log_g[:, None] * (L - 1.0 - m))
    return jnp.einsum('bhmd,bhme->bhde', k * w[..., None], v)


def _ret_heads(q, k, v, rope):
    B, T, _ = q.shape
    q = q.reshape(B, T, RT_HEADS, RT_DK)
    k = k.reshape(B, T, RT_HEADS, RT_DK) * (RT_DK ** -0.5)
    if rope is not None:
        q = _rope(q, *rope)
        k = _rope(k, *rope)
    v = v.reshape(B, T, RT_HEADS, RT_DV)
    return [a.transpose(0, 2, 1, 3).astype(jnp.float32) for a in (q, k, v)]


def _mix_ret(ql, kl, vl, gl, qc, kc, vc, gc, decay_logit, norm_g, rope, ctx_out):
    Ql, Kl, Vl = _ret_heads(ql, kl, vl, rope)
    Qc, Kc, Vc = _ret_heads(qc, kc, vc, None)
    log_g = jax.nn.log_sigmoid(decay_logit.astype(jnp.float32))
    B, H = Ql.shape[:2]
    yl = 0.0
    yc = 0.0
    for d in range(2):
        if d == 0:
            t = lambda a: a
        else:
            t = lambda a: jnp.flip(a, axis=2)
        if ctx_out:
            oc, R = _retention_scan(t(Qc), t(Kc), t(Vc), log_g[d],
                                    jnp.zeros((B, H, RT_DK, RT_DV), jnp.float32))
            yc = yc + t(oc)
        else:
            R = _retention_state(t(Kc), t(Vc), log_g[d])
        ol, _ = _retention_scan(t(Ql), t(Kl), t(Vl), log_g[d], R)
        yl = yl + t(ol)

    def post(y, g):
        Bq, Hq, T, dv = y.shape
        y = _rms(y.transpose(0, 2, 1, 3), norm_g).reshape(Bq, T, Hq * dv)
        return (y * jax.nn.silu(g.astype(jnp.float32))).astype(g.dtype)

    return post(yl, gl), (post(yc, gc) if ctx_out else None)


def _na_heads(q, k, v, qk_g):
    B, T, _ = q.shape
    q = _rms(q.reshape(B, T, NA_HEADS, NA_HEAD), qk_g[0])
    k = _rms(k.reshape(B, T, NA_HEADS, NA_HEAD), qk_g[1])
    return q, k, v.reshape(B, T, NA_HEADS, NA_HEAD)


def _na_latent(q, k, v, kc, vc, rpb, rows):
    B, S, H, d = q.shape
    kh = min(NA_KH, rows)
    scale = NA_HEAD ** -0.5
    qg = q.reshape(B, rows, GRID_W, H, d)
    kg = k.reshape(B, rows, GRID_W, H, d)
    vg = v.reshape(B, rows, GRID_W, H, d)
    cols = np.arange(GRID_W)
    col_start = np.clip(cols - NA_KW // 2, 0, GRID_W - NA_KW)
    col_idx = col_start[:, None] + np.arange(NA_KW)[None, :]
    dc = col_idx - cols[:, None] + (NA_KW - 1)
    rpb_c = rpb[:, :, dc]

    def row_fn(args):
        r, q_row = args
        rs = jnp.clip(r - kh // 2, 0, rows - kh)
        k_win = lax.dynamic_slice_in_dim(kg, rs, kh, axis=1)[:, :, col_idx]
        v_win = lax.dynamic_slice_in_dim(vg, rs, kh, axis=1)[:, :, col_idx]
        dr = rs + jnp.arange(kh) - r + (NA_KH - 1)
        bias = jnp.take(rpb_c, dr, axis=1).transpose(0, 2, 1, 3)
        s_loc = jnp.einsum('bchd,bicjhd->bhcij', q_row, k_win).astype(jnp.float32) * scale
        s_loc = s_loc + bias[None].astype(jnp.float32)
        s_ctx = jnp.einsum('bchd,blhd->bhcl', q_row, kc).astype(jnp.float32) * scale
        n_loc = kh * NA_KW
        s = jnp.concatenate([s_loc.reshape(B, H, GRID_W, n_loc), s_ctx], axis=-1)
        p = jax.nn.softmax(s, axis=-1).astype(v.dtype)
        p_loc = p[..., :n_loc].reshape(B, H, GRID_W, kh, NA_KW)
        p_ctx = p[..., n_loc:]
        return (jnp.einsum('bhcij,bicjhd->bchd', p_loc, v_win)
                + jnp.einsum('bhcl,blhd->bchd', p_ctx, vc))

    out = lax.map(row_fn, (jnp.arange(rows), jnp.moveaxis(qg, 1, 0)))
    return jnp.moveaxis(out, 0, 1).reshape(B, S, H * d)


def _mix_na(ql, kl, vl, qc, kc, vc, qk_g, rpb, rows, ctx_out):
    Ql, Kl, Vl = _na_heads(ql, kl, vl, qk_g)
    Qc, Kc, Vc = _na_heads(qc, kc, vc, qk_g)
    yl = _na_latent(Ql, Kl, Vl, Kc, Vc, rpb, rows)
    yc = None
    if ctx_out:
        B, L = Qc.shape[:2]
        o = _attn(Qc.transpose(0, 2, 1, 3), Kc.transpose(0, 2, 1, 3), Vc.transpose(0, 2, 1, 3),
                  NA_HEAD ** -0.5)
        yc = o.transpose(0, 2, 1, 3).reshape(B, L, NA_HEADS * NA_HEAD)
    return yl, yc


def _mla_heads(cq, ckv, kr, q_norm_g, kv_norm_g, w_uq, w_ukv, qk_g, rope):
    B, T, _ = cq.shape
    q = (_rms(cq, q_norm_g) @ w_uq).reshape(B, T, MLA_HEADS, MLA_NOPE + MLA_ROPE)
    kv = (_rms(ckv, kv_norm_g) @ w_ukv).reshape(B, T, MLA_HEADS, MLA_NOPE + MLA_V)
    k_nope, v = kv[..., :MLA_NOPE], kv[..., MLA_NOPE:]
    k = jnp.concatenate([k_nope, jnp.broadcast_to(kr[:, :, None, :], (B, T, MLA_HEADS, MLA_ROPE))], axis=-1)
    q = _rms(q, qk_g[0])
    k = _rms(k, qk_g[1])
    if rope is not None:
        q = jnp.concatenate([q[..., :MLA_NOPE], _rope(q[..., MLA_NOPE:], *rope)], axis=-1)
        k = jnp.concatenate([k[..., :MLA_NOPE], _rope(k[..., MLA_NOPE:], *rope)], axis=-1)
    return q.transpose(0, 2, 1, 3), k.transpose(0, 2, 1, 3), v.transpose(0, 2, 1, 3)


def _mix_mla(cql, ckvl, krl, cqc, ckvc, krc, q_norm_g, kv_norm_g, w_uq, w_ukv, qk_g, rope, ctx_out):
    scale = (MLA_NOPE + MLA_ROPE) ** -0.5
    Ql, Kl, Vl = _mla_heads(cql, ckvl, krl, q_norm_g, kv_norm_g, w_uq, w_ukv, qk_g, rope)
    Qc, Kc, Vc = _mla_heads(cqc, ckvc, krc, q_norm_g, kv_norm_g, w_uq, w_ukv, qk_g, None)
    K = jnp.concatenate([Kc, Kl], axis=2)
    V = jnp.concatenate([Vc, Vl], axis=2)
    yl = _map_query_blocks(lambda qb: _attn(qb, K, V, scale), Ql, axis=2)

    def post(y):
        B, H, T, dv = y.shape
        return y.transpose(0, 2, 1, 3).reshape(B, T, H * dv)

    yc = post(_attn(Qc, Kc, Vc, scale)) if ctx_out else None
    return post(yl), yc


def _merge(h, ys, w_branch, w_gate, b_gate, w_o):
    m = 0.0
    for n in range(N_BRANCH):
        gate = jax.nn.sigmoid(h @ w_gate[n] + b_gate[n])
        m = m + gate * (ys[n] @ w_branch[n])
    return m @ w_o


def _peer(h, w_query, sub_keys, u, v):
    B, T, D = h.shape
    hb_all = h.reshape(-1, PEER_BLOCK, D)
    kk = PEER_TOPK * PEER_TOPK

    def block(hb):
        q = (hb @ w_query).reshape(PEER_BLOCK, PEER_HEADS, 2, PEER_DQ // 2)
        s = jnp.einsum('phsd,hskd->phsk', q, sub_keys).astype(jnp.float32)
        top_s, top_i = lax.top_k(s, PEER_TOPK)
        cand_s = (top_s[:, :, 0, :, None] + top_s[:, :, 1, None, :]).reshape(PEER_BLOCK, PEER_HEADS, kk)
        cand_i = (top_i[:, :, 0, :, None] * PEER_NKEYS + top_i[:, :, 1, None, :]).reshape(PEER_BLOCK, PEER_HEADS, kk)
        sel_s, pos = lax.top_k(cand_s, PEER_TOPK)
        idx = jnp.take_along_axis(cand_i, pos, axis=-1)
        g = jax.nn.softmax(sel_s, axis=-1)
        ue = u[idx]
        ve = v[idx]
        a = jax.nn.gelu(jnp.einsum('pd,phkd->phk', hb, ue).astype(jnp.float32), approximate=False)
        return jnp.einsum('phk,phkd->pd', (g * a).astype(ve.dtype), ve)

    return lax.map(block, hb_all).reshape(B, T, D)


def _layer(x, xc, c, c_ctx, lp, layer_idx, last, rows, rope_a, rope_r):
    ctx_out = not last
    mod = jax.nn.silu(c) @ lp['w_mod'] + lp['b_mod']
    sh1, sc1, g1, sh2, sc2, g2 = [m[:, None, :] for m in jnp.split(mod, 6, axis=-1)]
    modc = jax.nn.silu(c_ctx) @ lp['w_mod'] + lp['b_mod']
    sh1c, sc1c, g1c, sh2c, sc2c, g2c = jnp.split(modc, 6)

    h = _modulate(x, lp['norm1_g'], sh1, sc1)
    hc = _modulate(xc, lp['norm1_g'], sh1c, sc1c)
    pl = _split_in(h @ lp['w_in'])
    pc = _split_in(hc @ lp['w_in'])

    lam_init = 0.8 - 0.6 * math.exp(-0.3 * layer_idx)
    yA = _mix_diff(pl[0], pl[1], pl[2], pc[0], pc[1], pc[2], lp['diff_lambda'], lp['diff_qk_g'],
                   lp['diff_sub_g'], lam_init, rope_a, ctx_out)
    yB = _mix_ret(pl[3], pl[4], pl[5], pl[6], pc[3], pc[4], pc[5], pc[6], lp['ret_decay'],
                  lp['ret_norm_g'], rope_r, ctx_out)
    yC = _mix_na(pl[7], pl[8], pl[9], pc[7], pc[8], pc[9], lp['na_qk_g'], lp['na_rpb'], rows, ctx_out)
    yD = _mix_mla(pl[10], pl[11], pl[12], pc[10], pc[11], pc[12], lp['mla_q_norm_g'],
                  lp['mla_kv_norm_g'], lp['w_uq'], lp['w_ukv'], lp['mla_qk_g'], rope_a, ctx_out)

    x = x + g1 * _merge(h, [yA[0], yB[0], yC[0], yD[0]], lp['w_branch'], lp['w_gate'], lp['b_gate'], lp['w_o'])
    x = x + g2 * _peer(_modulate(x, lp['norm2_g'], sh2, sc2), lp['peer_w_query'], lp['peer_sub_keys'],
                       lp['peer_u'], lp['peer_v'])
    if last:
        return x, None
    xc = xc + g1c * _merge(hc, [yA[1], yB[1], yC[1], yD[1]], lp['w_branch'], lp['w_gate'], lp['b_gate'], lp['w_o'])
    xc = xc + g2c * _peer(_modulate(xc, lp['norm2_g'], sh2c, sc2c), lp['peer_w_query'], lp['peer_sub_keys'],
                          lp['peer_u'], lp['peer_v'])
    return x, xc


def setup_inputs(seed: int = 0) -> dict:
    key = jax.random.key(seed)
    ks = jax.random.split(key, 32)
    f32 = jnp.float32
    D = D_MODEL

    def nrm(k, shape, scale):
        return jax.random.normal(k, shape, f32) * scale

    def gain(k, shape):
        return 1.0 + 0.02 * jax.random.normal(k, shape, f32)

    base = 1.0 - np.exp(np.linspace(np.log(1.0 / 32), np.log(1.0 / 512), RT_HEADS))
    decay_logit = np.log(base / (1.0 - base)).astype(np.float32)

    return {
        'x': nrm(ks[0], (BATCH, SEQ, D), 1.0),
        'c': nrm(ks[1], (BATCH, D), 1.0),
        'ctx': nrm(ks[2], (BATCH, CTX_LEN, D), 1.0),
        'c_ctx': nrm(ks[3], (D,), 1.0),
        'w_mod': nrm(ks[4], (DEPTH, D, 6 * D), 0.5 * D ** -0.5),
        'b_mod': nrm(ks[5], (DEPTH, 6 * D), 0.01),
        'norm1_g': gain(ks[6], (DEPTH, D)),
        'norm2_g': gain(ks[7], (DEPTH, D)),
        'w_in': nrm(ks[8], (DEPTH, D, IN_WIDTH), D ** -0.5),
        'diff_lambda': nrm(ks[9], (DEPTH, 4, DA_HEAD), 0.1),
        'diff_qk_g': gain(ks[10], (DEPTH, 2, DA_HEAD)),
        'diff_sub_g': gain(ks[11], (DEPTH, DA_V)),
        'ret_decay': jnp.asarray(decay_logit)[None, None, :] + nrm(ks[12], (DEPTH, 2, RT_HEADS), 0.1),
        'ret_norm_g': gain(ks[13], (DEPTH, RT_DV)),
        'na_qk_g': gain(ks[14], (DEPTH, 2, NA_HEAD)),
        'na_rpb': nrm(ks[15], (DEPTH, NA_HEADS, 2 * NA_KH - 1, 2 * NA_KW - 1), 0.02),
        'mla_q_norm_g': gain(ks[16], (DEPTH, MLA_Q_LORA)),
        'mla_kv_norm_g': gain(ks[17], (DEPTH, MLA_KV_LORA)),
        'w_uq': nrm(ks[18], (DEPTH, MLA_Q_LORA, MLA_HEADS * (MLA_NOPE + MLA_ROPE)), MLA_Q_LORA ** -0.5),
        'w_ukv': nrm(ks[19], (DEPTH, MLA_KV_LORA, MLA_HEADS * (MLA_NOPE + MLA_V)), MLA_KV_LORA ** -0.5),
        'mla_qk_g': gain(ks[20], (DEPTH, 2, MLA_NOPE + MLA_ROPE)),
        'w_branch': nrm(ks[21], (DEPTH, N_BRANCH, BRANCH_W, D), BRANCH_W ** -0.5),
        'w_gate': nrm(ks[22], (DEPTH, N_BRANCH, D, D), D ** -0.5),
        'b_gate': nrm(ks[23], (DEPTH, N_BRANCH, D), 0.01),
        'w_o': nrm(ks[24], (DEPTH, D, D), D ** -0.5),
        'peer_w_query': nrm(ks[25], (DEPTH, D, PEER_HEADS * PEER_DQ), D ** -0.5),
        'peer_sub_keys': nrm(ks[26], (DEPTH, PEER_HEADS, 2, PEER_NKEYS, PEER_DQ // 2), (PEER_DQ // 2) ** -0.5),
        'peer_u': nrm(ks[27], (DEPTH, PEER_EXPERTS, D), D ** -0.5),
        'peer_v': nrm(ks[28], (DEPTH, PEER_EXPERTS, D), PEER_HEADS ** -0.5),
    }


def reference(x, c, ctx, c_ctx, w_mod, b_mod, norm1_g, norm2_g, w_in, diff_lambda, diff_qk_g,
              diff_sub_g, ret_decay, ret_norm_g, na_qk_g, na_rpb, mla_q_norm_g, mla_kv_norm_g,
              w_uq, w_ukv, mla_qk_g, w_branch, w_gate, b_gate, w_o, peer_w_query, peer_sub_keys,
              peer_u, peer_v):
    n_tok = x.shape[1]
    rows = n_tok // GRID_W
    rope_a = _rope_tables(n_tok, DA_HEAD)
    rope_r = _rope_tables(n_tok, RT_DK)
    xc = ctx
    for l in range(DEPTH):
        lp = dict(w_mod=w_mod[l], b_mod=b_mod[l], norm1_g=norm1_g[l], norm2_g=norm2_g[l],
                  w_in=w_in[l], diff_lambda=diff_lambda[l], diff_qk_g=diff_qk_g[l],
                  diff_sub_g=diff_sub_g[l], ret_decay=ret_decay[l], ret_norm_g=ret_norm_g[l],
                  na_qk_g=na_qk_g[l], na_rpb=na_rpb[l], mla_q_norm_g=mla_q_norm_g[l],
                  mla_kv_norm_g=mla_kv_norm_g[l], w_uq=w_uq[l], w_ukv=w_ukv[l],
                  mla_qk_g=mla_qk_g[l], w_branch=w_branch[l], w_gate=w_gate[l],
                  b_gate=b_gate[l], w_o=w_o[l], peer_w_query=peer_w_query[l],
                  peer_sub_keys=peer_sub_keys[l], peer_u=peer_u[l], peer_v=peer_v[l])
        x, xc = _layer(x, xc, c, c_ctx, lp, l, l == DEPTH - 1, rows, rope_a, rope_r)
    return x
```

```cpp
#include <hip/hip_runtime.h>
#include <cstdio>
#include <cstdint>

#ifndef MK_ONE_LAUNCH
#define MK_ONE_LAUNCH 1
#endif
#ifndef PEER_SLICED
#define PEER_SLICED 1
#endif
#ifndef PROJ_FP8
#define PROJ_FP8 1
#endif
#ifndef PROJ_F8_MASK
#define PROJ_F8_MASK 0xFFFFFFu
#endif
#define PROJ_BF16_TILES ((PROJ_FP8 ? (0xFFFFFFu & ~(PROJ_F8_MASK)) : 0xFFFFFFu) != 0u)
#ifndef STAG_PROJ
#define STAG_PROJ 0
#define STAG_Z 0
#define STAG_G 0
#endif
#ifndef PROBE_PH
#define PROBE_PH -1
#endif
#ifndef PROBE_N
#define PROBE_N 1
#endif

typedef unsigned short bf16_t;
typedef short bf16x8 __attribute__((ext_vector_type(8)));
typedef short s16x4 __attribute__((ext_vector_type(4)));
typedef float f32x4 __attribute__((ext_vector_type(4)));
typedef float f32x2 __attribute__((ext_vector_type(2)));
typedef float f32x16 __attribute__((ext_vector_type(16)));
typedef unsigned u32x4 __attribute__((ext_vector_type(4)));
typedef int i32x4 __attribute__((ext_vector_type(4)));
typedef unsigned u32x2 __attribute__((ext_vector_type(2)));
#define DEV __device__ __forceinline__
#define LAS __attribute__((address_space(3)))

typedef __bf16 bf16v2_t __attribute__((ext_vector_type(2)));
DEV unsigned cvtpk_v(float lo, float hi) { const f32x2 v = {lo, hi}; return __builtin_bit_cast(unsigned, __builtin_convertvector(v, bf16v2_t)); }
DEV unsigned cvtpk(float lo, float hi) { unsigned r; asm volatile("v_cvt_pk_bf16_f32 %0, %1, %2" : "=v"(r) : "v"(lo), "v"(hi)); return r; }
DEV float bf2f(bf16_t x) { return __uint_as_float(((unsigned)x) << 16); }
DEV float bflo(unsigned w) { return __uint_as_float(w << 16); }
DEV float bfhi(unsigned w) { return __uint_as_float(w & 0xffff0000u); }
DEV bf16_t f2bf(float x) { return (bf16_t)(cvtpk(x, x) & 0xffffu); }
template <int CTRL> DEV float dppf(float v) { return __uint_as_float((unsigned)__builtin_amdgcn_update_dpp(0, (int)__float_as_uint(v), CTRL, 0xF, 0xF, true)); }
DEV float red8(float v) { v += dppf<0xB1>(v); v += dppf<0x4E>(v); v += dppf<0x141>(v); return v; }
template <int MASK> DEV float xshf(float v) {
    if constexpr (MASK == 1) return dppf<0xB1>(v);
    else if constexpr (MASK == 2) return dppf<0x4E>(v);
    else if constexpr (MASK == 8) return dppf<0x128>(v);
    else if constexpr (MASK == 32) { const unsigned u = __float_as_uint(v); auto r = __builtin_amdgcn_permlane32_swap(u, u, false, false); return __uint_as_float(r[0] ^ r[1] ^ u); }
    else return __uint_as_float((unsigned)__builtin_amdgcn_ds_swizzle((int)__float_as_uint(v), (MASK << 10) | 0x1F));
}
DEV float wave_sum(float v) {
    v += xshf<1>(v); v += xshf<2>(v); v += xshf<4>(v); v += xshf<8>(v); v += xshf<16>(v);
    { auto r = __builtin_amdgcn_permlane32_swap(__float_as_uint(v), __float_as_uint(v), false, false); v = __uint_as_float(r[0]) + __uint_as_float(r[1]); }
    return v;
}
extern __shared__ __attribute__((aligned(16))) char g_smem[];
constexpr int LDS_WTAB = 131072 + 16;
DEV int hw_slot() { return __builtin_amdgcn_s_getreg((5 << 11) | 4) & 63; }
DEV void lid_init() { if ((threadIdx.x & 63) == 0) ((LAS int*)(g_smem + LDS_WTAB))[hw_slot()] = (int)(threadIdx.x >> 6); __syncthreads(); }
DEV int lid() { const int w = __builtin_amdgcn_readfirstlane(((const LAS int*)(g_smem + LDS_WTAB))[hw_slot()]);
    int ln; asm volatile("v_mbcnt_lo_u32_b32 %0, -1, 0\n\tv_mbcnt_hi_u32_b32 %0, -1, %0" : "=v"(ln));
    return (w << 6) | ln; }
DEV int at_crow(int r, int hi) { return (r & 3) + 8 * (r >> 2) + 4 * hi; }
DEV float sigmoidf_(float x) { return __builtin_amdgcn_rcpf(1.f + __expf(-x)); }
DEV float siluf_(float x) { return x * __builtin_amdgcn_rcpf(1.f + __expf(-x)); }

constexpr int TL = 16384, TC = 2048, TA = 18432, DM = 2048, INW = 5952, INP = 6144;
constexpr int NB = 8, SEQ = 2048, CTX = 256;
constexpr float EPS = 1e-6f;
constexpr int C_DAQ = 0, C_DAK = 512, C_DAV = 1024, C_RTQ = 1536, C_RTK = 2048, C_RTV = 2560, C_RTG = 3072;
constexpr int C_NAQ = 3584, C_NAK = 4096, C_NAV = 4608, C_MCQ = 5120, C_MKV = 5632, C_MKR = 5888;

constexpr size_t AL(size_t x) { return (x + 255) / 256 * 256; }
constexpr size_t OFF_BAR = 0;
constexpr size_t OFF_MOD = 16384;
constexpr size_t SZ_MOD = (size_t)2 * 9 * 12288 * 4;
constexpr size_t OFF_ROPEA = AL(OFF_MOD + SZ_MOD);
constexpr size_t OFF_ROPER = OFF_ROPEA + 2 * 64 * 16 * 4;
constexpr size_t OFF_MISC = OFF_ROPER + 2 * 64 * 32 * 4;
constexpr size_t OFF_XC = 1u << 20;
constexpr size_t OFF_H = OFF_XC + (size_t)TC * DM * 4;
constexpr size_t OFF_PROJ = OFF_H + (size_t)TA * DM * 2;
constexpr size_t OFF_QM = OFF_PROJ + (size_t)TA * INP * 2;
constexpr size_t OFF_KVM = OFF_QM + (size_t)TA * 768 * 2;
constexpr size_t OFF_KM = OFF_KVM + (size_t)TA * 1024 * 2;
constexpr size_t OFF_Y = OFF_KM + (size_t)TA * 768 * 2;
constexpr size_t OFF_M = OFF_Y + (size_t)TA * DM * 2;
constexpr size_t OFF_ST = OFF_M + (size_t)TA * DM * 2;
constexpr size_t OFF_RT = OFF_ST + (size_t)1152 * 16384 * 4;
constexpr size_t OFF_PIDX = OFF_RT + (size_t)1152 * 16384 * 2;
constexpr size_t OFF_PW = OFF_PIDX + (size_t)TA * 128 * 4;
constexpr size_t OFF_W = OFF_PW + (size_t)TA * 128 * 4;
constexpr size_t OFF_Z = OFF_PROJ;
constexpr size_t OFF_SC = OFF_PROJ;
constexpr size_t OFF_QP = OFF_Y;
static_assert((size_t)TA * 8192 * 2 <= OFF_Y - OFF_PROJ, "Z overlay");
static_assert((size_t)16 * 128 * TA * 4 <= OFF_Y - OFF_PROJ, "SC overlay");
constexpr size_t W_IN = 0;
constexpr size_t W_G = W_IN + (size_t)INP * DM * 2;
constexpr size_t W_B = W_G + (size_t)8192 * DM;
constexpr size_t W_O = W_B + (size_t)4 * 2048 * 512 * 2;
constexpr size_t W_Q = W_O + (size_t)DM * DM * 2;
constexpr size_t W_UQ = W_Q + (size_t)DM * DM * 2;
constexpr size_t W_UKV = W_UQ + (size_t)768 * 512 * 2;
constexpr size_t W_SK = W_UKV + (size_t)1024 * 256 * 2;
constexpr size_t W_U = W_SK + (size_t)262144 * 2;
constexpr size_t W_V = W_U + (size_t)16384 * DM;
constexpr size_t W_US = W_V + (size_t)16384 * DM;
constexpr size_t W_VS = W_US + 65536;
constexpr size_t W_IN8 = W_VS + 65536;
constexpr size_t W_LAYER = W_IN8 + (size_t)INP * DM;
constexpr size_t OFF_H8 = OFF_W + 2 * W_LAYER;
constexpr size_t OFF_XB = OFF_H8 + (size_t)TA * DM;
constexpr size_t WS_NEED = OFF_XB + (size_t)TA * DM * 2;

struct P {
    const float *x, *c, *ctx, *c_ctx, *w_mod, *b_mod, *norm1_g, *norm2_g, *w_in, *diff_lambda, *diff_qk_g, *diff_sub_g, *ret_decay, *ret_norm_g,
        *na_qk_g, *na_rpb, *mla_q_norm_g, *mla_kv_norm_g, *w_uq, *w_ukv, *mla_qk_g, *w_branch, *w_gate, *b_gate, *w_o, *peer_w_query, *peer_sub_keys,
        *peer_u, *peer_v;
    float* out;
    char* ws;
};
DEV bf16_t* wsb(const P& p, size_t off) { return (bf16_t*)(p.ws + off); }
DEV float* wsf(const P& p, size_t off) { return (float*)(p.ws + off); }
DEV bf16_t* wl(const P& p, int l, size_t off) { return (bf16_t*)(p.ws + OFF_W + (size_t)l * W_LAYER + off); }

namespace g8 {
constexpr int BM = 256, BK = 64, HALF = 128, HTB = HALF * BK * 2, SHM_B = 8 * HTB;
DEV int lds_byte(int r, int c) { int st = (r >> 4) * 2 + (c >> 5), rr = r & 15, cc = c & 31, ob = rr * 64 + cc * 2; return st * 1024 + (ob ^ (((ob >> 9) & 1) << 5)); }
DEV void stage_rc(int b, int& R, int& C) { int st = b / 1024, sb = b % 1024, swz = sb ^ (((sb >> 9) & 1) << 5); R = (st >> 1) * 16 + swz / 64; C = (st & 1) * 32 + (swz % 64) / 2; }
DEV int perm32(int rho) { const int n = rho >> 4, i = rho & 15; return 8 * (i >> 2) + 4 * n + (i & 3); }
struct Unit { int pm, pn, g; };
struct Order {
    int nM, nN, NG, G, c; unsigned cmask = 0u;
    int stagger = 0;
    DEV bool next(int i, Unit& u) const {
        const int per = nM * nN; const long L = (long)i * G + c; if (L >= (long)per * NG) return false;
        u.g = (int)(L / per); int wgid = (int)(L % per);
        { const int q = per / 8, r = per % 8, xcd = wgid % 8, off = wgid / 8; wgid = (xcd < r ? xcd * (q + 1) : r * (q + 1) + (xcd - r) * q) + off; }
        const int nig = 8 * nN, gid = wgid / nig, fm = gid * 8, gsz = (nM - fm) < 8 ? (nM - fm) : 8;
        u.pm = fm + ((wgid % nig) % gsz); u.pn = (wgid % nig) / gsz;
        if (cmask) { unsigned m = cmask; for (int k = u.pn; k > 0; --k) m &= m - 1u; u.pn = __builtin_ctz(m); }
        return true;
    }
};
template <int LDA, int KK, bool PERM, class Epi, bool TRANSP = true>
DEV void gemm_stream(const bf16_t* __restrict__ A, size_t GA, const bf16_t* __restrict__ Bt, size_t GB, const Order S, const Epi& E, char* smem) {
    LAS unsigned char* lds = (LAS unsigned char*)smem;
    const int tid = lid(), wid = __builtin_amdgcn_readfirstlane(tid >> 6), lane = tid & 63, wr = wid >> 2, wc = wid & 3, fr = lane & 15, fq = lane >> 4;
    constexpr int nt = KK / BK;
    unsigned voffA[2], voffB[2];
#pragma unroll
    for (int i = 0; i < 2; ++i) { int R, C; stage_rc(tid * 16 + i * 8192, R, C); const int Rb = PERM ? ((R & ~31) + perm32(R & 31)) : R;
        voffA[i] = (unsigned)(R * LDA + C) * 2u; voffB[i] = (unsigned)(Rb * KK + C) * 2u; }
    constexpr size_t kstep = (size_t)(BK * 2), hstepA = (size_t)HALF * LDA * 2, hstepB = (size_t)HALF * KK * 2;
    const unsigned ldsw = (unsigned)wid * 1024u;
    const int aoff = lds_byte(wr * 64 + fr, fq * 8), boff = lds_byte(wc * 32 + fr, fq * 8);
    LAS unsigned char* ldsB = lds + 4 * HTB + boff;
#define G_SA(b, h) (((b) * 2 + (h)) * HTB)
#define G_SB(b, h) ((4 + (b) * 2 + (h)) * HTB)
#define G_STAGE(bufoff, soff, voff, RS) do { _Pragma("unroll") for (int _i = 0; _i < 2; ++_i) \
        __builtin_amdgcn_raw_ptr_buffer_load_lds(RS, (LAS void*)(lds + (bufoff) + ldsw + _i * 8192), 16, (int)(voff)[_i], (int)(soff), 0, 0); } while (0)
#define G_LDA(dst, b, h) do { _Pragma("unroll") for (int m = 0; m < 4; ++m) _Pragma("unroll") for (int k = 0; k < 2; ++k) dst[m][k] = *(const LAS bf16x8*)(lds + G_SA(b, h) + aoff + m * 2048 + k * 1024); } while (0)
#define G_LDB(dst, b, h) do { _Pragma("unroll") for (int n = 0; n < 2; ++n) _Pragma("unroll") for (int k = 0; k < 2; ++k) dst[n][k] = *(const LAS bf16x8*)(ldsB + (((b) * 2 + (h)) * HTB + n * 2048 + k * 1024)); } while (0)
#define G_MMA(ai, bj, At_, Bt_) do { __builtin_amdgcn_s_setprio(1); _Pragma("unroll") for (int m = 0; m < 4; ++m) _Pragma("unroll") for (int n = 0; n < 2; ++n) _Pragma("unroll") for (int k = 0; k < 2; ++k) \
        acc[ai][bj][m][n] = TRANSP ? __builtin_amdgcn_mfma_f32_16x16x32_bf16(Bt_[n][k], At_[m][k], acc[ai][bj][m][n], 0, 0, 0) : __builtin_amdgcn_mfma_f32_16x16x32_bf16(At_[m][k], Bt_[n][k], acc[ai][bj][m][n], 0, 0, 0); __builtin_amdgcn_s_setprio(0); } while (0)
#define G_WAIT_V(n) asm volatile("s_waitcnt vmcnt(" #n ")" ::: "memory")
#define G_WAIT_L(n) asm volatile("s_waitcnt lgkmcnt(" #n ")" ::: "memory")
#define G_BAR __builtin_amdgcn_s_barrier()
#define G_SCHED __builtin_amdgcn_sched_barrier(0)
#define G_ABASE(u) ((int)(((u).g * (int)GA + (u).pm * 256 * LDA) * 2))
#define G_BBASE(u) ((int)(((u).g * (int)GB + (u).pn * 256 * KK) * 2))
    const __amdgpu_buffer_rsrc_t rsA = __builtin_amdgcn_make_buffer_rsrc((void*)A, 0, -1, 0x00020000), rsB = __builtin_amdgcn_make_buffer_rsrc((void*)Bt, 0, -1, 0x00020000);
    Unit cur, nxt; int ui = 0;
    if (!S.next(0, cur)) return;
    if (S.stagger > 0 && ((S.c >> 3) & 1)) { for (int z = 0; z < S.stagger; ++z) __builtin_amdgcn_s_sleep(127); }
    f32x4 acc[2][2][4][2];
#pragma unroll
    for (int a_ = 0; a_ < 2; ++a_)
#pragma unroll
        for (int b_ = 0; b_ < 2; ++b_)
#pragma unroll
            for (int m = 0; m < 4; ++m)
#pragma unroll
                for (int n = 0; n < 2; ++n) acc[a_][b_][m][n] = (f32x4){0.f, 0.f, 0.f, 0.f};
    bf16x8 At[4][2], B0[2][2], B1[2][2];
    int cA = G_ABASE(cur), cB = G_BBASE(cur);
    __syncthreads();
    G_STAGE(G_SB(0, 0), cB, voffB, rsB); G_STAGE(G_SA(0, 0), cA, voffA, rsA); G_STAGE(G_SB(0, 1), cB + (int)hstepB, voffB, rsB); G_STAGE(G_SA(0, 1), cA + (int)hstepA, voffA, rsA);
    if (wr == 1) G_BAR;
    G_WAIT_V(4); G_BAR;
    G_STAGE(G_SB(1, 0), cB + (int)kstep, voffB, rsB); G_STAGE(G_SA(1, 0), cA + (int)kstep, voffA, rsA); G_STAGE(G_SB(1, 1), cB + (int)(hstepB + kstep), voffB, rsB);
    G_WAIT_V(6); G_BAR;
    for (;;) {
        const bool has_next = S.next(ui + 1, nxt);
        const int nA = has_next ? G_ABASE(nxt) : cA, nB = has_next ? G_BBASE(nxt) : cB;
        for (int t = 0; t < nt; t += 2) {
            const bool last = (t == nt - 2);
            const int a1 = cA + (t + 1) * (int)kstep;
            const int a2 = last ? nA : cA + (t + 2) * (int)kstep, b2 = last ? nB : cB + (t + 2) * (int)kstep;
            const int a3 = a2 + (int)kstep, b3 = b2 + (int)kstep;
            G_LDB(B0, 0, 0); G_SCHED; G_LDA(At, 0, 0); G_STAGE(G_SA(1, 1), a1 + (int)hstepA, voffA, rsA);
            G_WAIT_L(8); G_BAR; G_WAIT_L(0); G_MMA(0, 0, At, B0); G_BAR; G_SCHED;
            G_LDB(B1, 0, 1); G_STAGE(G_SB(0, 0), b2, voffB, rsB);
            G_BAR; G_WAIT_L(0); G_MMA(0, 1, At, B1); G_BAR;
            G_LDA(At, 0, 1); G_STAGE(G_SA(0, 0), a2, voffA, rsA);
            G_BAR; G_WAIT_L(0); G_MMA(1, 0, At, B0); G_BAR; G_SCHED;
            G_STAGE(G_SB(0, 1), b2 + (int)hstepB, voffB, rsB);
            G_WAIT_V(6); G_BAR; G_MMA(1, 1, At, B1); G_BAR;
            G_LDB(B0, 1, 0); G_SCHED; G_LDA(At, 1, 0); G_STAGE(G_SA(0, 1), a2 + (int)hstepA, voffA, rsA);
            G_WAIT_L(8); G_BAR; G_WAIT_L(0); G_MMA(0, 0, At, B0); G_BAR; G_SCHED;
            G_LDB(B1, 1, 1); G_STAGE(G_SB(1, 0), b3, voffB, rsB);
            G_BAR; G_WAIT_L(0); G_MMA(0, 1, At, B1); G_BAR;
            G_LDA(At, 1, 1); G_STAGE(G_SA(1, 0), a3, voffA, rsA);
            G_BAR; G_WAIT_L(0); G_MMA(1, 0, At, B0); G_BAR; G_SCHED;
            G_STAGE(G_SB(1, 1), b3 + (int)hstepB, voffB, rsB);
            G_WAIT_V(6); G_BAR; G_MMA(1, 1, At, B1); G_BAR;
        }
        { const int tz = lid();
          const int wz = tz >> 6, lz = tz & 63; E(acc, cur, wz >> 2, wz & 3, lz & 15, lz >> 4); }
        if (!has_next) break;
#pragma unroll
        for (int a_ = 0; a_ < 2; ++a_)
#pragma unroll
            for (int b_ = 0; b_ < 2; ++b_)
#pragma unroll
                for (int m = 0; m < 4; ++m)
#pragma unroll
                    for (int n = 0; n < 2; ++n) acc[a_][b_][m][n] = (f32x4){0.f, 0.f, 0.f, 0.f};
        cur = nxt; cA = nA; cB = nB; ++ui;
    }
    G_WAIT_V(0);
    if (wr == 0) G_BAR;
    G_BAR;
#undef G_SA
#undef G_SB
#undef G_STAGE
#undef G_LDA
#undef G_LDB
#undef G_MMA
#undef G_ABASE
#undef G_BBASE
}

typedef int v8i __attribute__((ext_vector_type(8)));
DEV int swz8(int r) { return ((r >> 1) & 1) | (((r >> 2) & 1) << 2); }
template <int KB, bool PERM, class Epi>
DEV void gemm_stream_f8(const unsigned char* __restrict__ A, const unsigned char* __restrict__ Bt, const Order S, const Epi& E, char* smem) {
    LAS unsigned char* lds = (LAS unsigned char*)smem;
    const int tid = lid(), wid = __builtin_amdgcn_readfirstlane(tid >> 6), lane = tid & 63, wr = wid >> 2, wc = wid & 3, fr = lane & 15, fq = lane >> 4;
    constexpr int nt = KB / 128;
    unsigned voff[2], voffB[2];
#pragma unroll
    for (int i = 0; i < 2; ++i) { const int q = tid + i * 512, R = q >> 3, sl = q & 7, pc = sl ^ swz8(R & 15); voff[i] = (unsigned)(R * KB + pc * 16);
        const int Rb = PERM ? ((R & ~31) + perm32(R & 31)) : R; voffB[i] = (unsigned)(Rb * KB + pc * 16); }
    constexpr size_t kstep = 128, hstep = (size_t)HALF * KB;
    const unsigned ldsw = (unsigned)wid * 1024u;
    const int sw = swz8(fr);
    const int aoff = (wr * 64 + fr) * 128 + (((2 * fq) ^ sw) << 4), boff = (wc * 32 + fr) * 128 + (((2 * fq) ^ sw) << 4);
    const int aoff2 = aoff ^ 16, boff2 = boff ^ 16;
    LAS unsigned char* ldsB1 = lds + 4 * HTB + boff; LAS unsigned char* ldsB2 = lds + 4 * HTB + boff2;
#define G_SA(b, h) (((b) * 2 + (h)) * HTB)
#define G_SB(b, h) ((4 + (b) * 2 + (h)) * HTB)
#define G_STAGE(bufoff, soff, RS) do { _Pragma("unroll") for (int _i = 0; _i < 2; ++_i) \
        __builtin_amdgcn_raw_ptr_buffer_load_lds(RS, (LAS void*)(lds + (bufoff) + ldsw + _i * 8192), 16, (int)((bufoff) >= 4 * HTB ? voffB[_i] : voff[_i]), (int)(soff), 0, 0); } while (0)
#define G_LD8(dst, base, base2) do { const u32x4 _a = *(const LAS u32x4*)(lds + (base)), _b = *(const LAS u32x4*)(lds + (base2)); \
        dst = (v8i){(int)_a.x, (int)_a.y, (int)_a.z, (int)_a.w, (int)_b.x, (int)_b.y, (int)_b.z, (int)_b.w}; } while (0)
#define G_LDA(dst, b, h) do { _Pragma("unroll") for (int m = 0; m < 4; ++m) G_LD8(dst[m], G_SA(b, h) + aoff + m * 2048, G_SA(b, h) + aoff2 + m * 2048); } while (0)
#define G_LDB(dst, b, h) do { _Pragma("unroll") for (int n = 0; n < 2; ++n) { const u32x4 _a = *(const LAS u32x4*)(ldsB1 + (((b) * 2 + (h)) * HTB + n * 2048)), _b = *(const LAS u32x4*)(ldsB2 + (((b) * 2 + (h)) * HTB + n * 2048)); \
        dst[n] = (v8i){(int)_a.x, (int)_a.y, (int)_a.z, (int)_a.w, (int)_b.x, (int)_b.y, (int)_b.z, (int)_b.w}; } } while (0)
#define G_MMA(ai, bj, At_, Bt_) do { __builtin_amdgcn_s_setprio(1); _Pragma("unroll") for (int m = 0; m < 4; ++m) _Pragma("unroll") for (int n = 0; n < 2; ++n) \
        acc[ai][bj][m][n] = __builtin_amdgcn_mfma_scale_f32_16x16x128_f8f6f4(Bt_[n], At_[m], acc[ai][bj][m][n], 0, 0, 0, 0x7F7F7F7F, 0, 0x7F7F7F7F); __builtin_amdgcn_s_setprio(0); } while (0)
#define G_ABASE(u) ((int)((u).pm * 256 * KB))
#define G_BBASE(u) ((int)((u).pn * 256 * KB))
    const __amdgpu_buffer_rsrc_t rsA = __builtin_amdgcn_make_buffer_rsrc((void*)A, 0, -1, 0x00020000), rsB = __builtin_amdgcn_make_buffer_rsrc((void*)Bt, 0, -1, 0x00020000);
    Unit cur, nxt; int ui = 0;
    if (!S.next(0, cur)) return;
    if (S.stagger > 0 && ((S.c >> 3) & 1)) { for (int z = 0; z < S.stagger; ++z) __builtin_amdgcn_s_sleep(127); }
    f32x4 acc[2][2][4][2];
#pragma unroll
    for (int a_ = 0; a_ < 2; ++a_)
#pragma unroll
        for (int b_ = 0; b_ < 2; ++b_)
#pragma unroll
            for (int m = 0; m < 4; ++m)
#pragma unroll
                for (int n = 0; n < 2; ++n) acc[a_][b_][m][n] = (f32x4){0.f, 0.f, 0.f, 0.f};
    v8i At[4], B0[2], B1[2];
    int cA = G_ABASE(cur), cB = G_BBASE(cur);
    __syncthreads();
    G_STAGE(G_SB(0, 0), cB, rsB); G_STAGE(G_SA(0, 0), cA, rsA); G_STAGE(G_SB(0, 1), cB + (int)hstep, rsB); G_STAGE(G_SA(0, 1), cA + (int)hstep, rsA);
    if (wr == 1) G_BAR;
    G_WAIT_V(4); G_BAR;
    G_STAGE(G_SB(1, 0), cB + (int)kstep, rsB); G_STAGE(G_SA(1, 0), cA + (int)kstep, rsA); G_STAGE(G_SB(1, 1), cB + (int)(hstep + kstep), rsB);
    G_WAIT_V(6); G_BAR;
    for (;;) {
        const bool has_next = S.next(ui + 1, nxt);
        const int nA = has_next ? G_ABASE(nxt) : cA, nB = has_next ? G_BBASE(nxt) : cB;
        for (int t = 0; t < nt; t += 2) {
            const bool last = (t == nt - 2);
            const int a1 = cA + (t + 1) * (int)kstep;
            const int a2 = last ? nA : cA + (t + 2) * (int)kstep, b2 = last ? nB : cB + (t + 2) * (int)kstep;
            const int a3 = a2 + (int)kstep, b3 = b2 + (int)kstep;
            G_LDB(B0, 0, 0); G_SCHED; G_LDA(At, 0, 0); G_STAGE(G_SA(1, 1), a1 + (int)hstep, rsA);
            G_WAIT_L(8); G_BAR; G_WAIT_L(0); G_MMA(0, 0, At, B0); G_BAR; G_SCHED;
            G_LDB(B1, 0, 1); G_STAGE(G_SB(0, 0), b2, rsB);
            G_BAR; G_WAIT_L(0); G_MMA(0, 1, At, B1); G_BAR;
            G_LDA(At, 0, 1); G_STAGE(G_SA(0, 0), a2, rsA);
            G_BAR; G_WAIT_L(0); G_MMA(1, 0, At, B0); G_BAR; G_SCHED;
            G_STAGE(G_SB(0, 1), b2 + (int)hstep, rsB);
            G_WAIT_V(6); G_BAR; G_MMA(1, 1, At, B1); G_BAR;
            G_LDB(B0, 1, 0); G_SCHED; G_LDA(At, 1, 0); G_STAGE(G_SA(0, 1), a2 + (int)hstep, rsA);
            G_WAIT_L(8); G_BAR; G_WAIT_L(0); G_MMA(0, 0, At, B0); G_BAR; G_SCHED;
            G_LDB(B1, 1, 1); G_STAGE(G_SB(1, 0), b3, rsB);
            G_BAR; G_WAIT_L(0); G_MMA(0, 1, At, B1); G_BAR;
            G_LDA(At, 1, 1); G_STAGE(G_SA(1, 0), a3, rsA);
            G_BAR; G_WAIT_L(0); G_MMA(1, 0, At, B0); G_BAR; G_SCHED;
            G_STAGE(G_SB(1, 1), b3 + (int)hstep, rsB);
            G_WAIT_V(6); G_BAR; G_MMA(1, 1, At, B1); G_BAR;
        }
        { const int tz = lid();
          const int wz = tz >> 6, lz = tz & 63; E(acc, cur, wz >> 2, wz & 3, lz & 15, lz >> 4); }
        if (!has_next) break;
#pragma unroll
        for (int a_ = 0; a_ < 2; ++a_)
#pragma unroll
            for (int b_ = 0; b_ < 2; ++b_)
#pragma unroll
                for (int m = 0; m < 4; ++m)
#pragma unroll
                    for (int n = 0; n < 2; ++n) acc[a_][b_][m][n] = (f32x4){0.f, 0.f, 0.f, 0.f};
        cur = nxt; cA = nA; cB = nB; ++ui;
    }
    G_WAIT_V(0);
    if (wr == 0) G_BAR;
    G_BAR;
#undef G_SA
#undef G_SB
#undef G_STAGE
#undef G_LD8
#undef G_LDA
#undef G_LDB
#undef G_MMA
#undef G_ABASE
#undef G_BBASE
}

struct EpiBf16 {
    bf16_t* C; long ldc; long gc; bool commit = true; float asc = 1.f;
    DEV void operator()(const f32x4 (&acc)[2][2][4][2], const Unit& u, int wr, int wc, int fr, int fq) const {
        if (!commit && acc[0][0][0][0][0] != 1.2345e30f) return;
        const char* ub = (const char*)(C + (size_t)u.g * gc + (size_t)(u.pm * 256) * ldc + u.pn * 256);
        const unsigned lo = (unsigned)((wr * 64 + fr) * (int)ldc + wc * 32 + fq * 8) * 2u;
#pragma unroll
        for (int ai = 0; ai < 2; ++ai)
#pragma unroll
            for (int m = 0; m < 4; ++m) {
#pragma unroll
                for (int bj = 0; bj < 2; ++bj) {
                    const f32x4 v0 = acc[ai][bj][m][0] * asc, v1 = acc[ai][bj][m][1] * asc; u32x4 w; w.x = cvtpk_v(v0[0], v0[1]); w.y = cvtpk_v(v0[2], v0[3]); w.z = cvtpk_v(v1[0], v1[1]); w.w = cvtpk_v(v1[2], v1[3]);
                    *(u32x4*)(ub + (lo + (unsigned)(((ai * 128 + m * 16) * (int)ldc + bj * 128) * 2))) = w;
                }
            }
    }
};
template <bool INBF> struct EpiResidB {
    const float *xin_l, *xin_c; bf16_t* xb; const float* gate;
    DEV void operator()(const f32x4 (&acc)[2][2][4][2], const Unit& u, int wr, int wc, int fr, int fq) const {
        const int brow = u.pm * 256, bcol = u.pn * 256;
        const bool isc = brow >= TL; const int r = isc ? 8 : (brow >> 11);
        const float* g = gate + (long)r * 12288 + bcol + wc * 32 + fq * 8;
        f32x4 gv[2][2];
#pragma unroll
        for (int bj = 0; bj < 2; ++bj) { gv[bj][0] = *(const f32x4*)(g + bj * 128); gv[bj][1] = *(const f32x4*)(g + bj * 128 + 4); }
        const size_t e0 = ((size_t)brow + wr * 64 + fr) * DM + bcol + wc * 32 + fq * 8;
        const char* xi = (const char*)((isc ? xin_c - (size_t)TL * DM : xin_l) + e0); char* xo = (char*)(xb + e0);
#pragma unroll
        for (int ai = 0; ai < 2; ++ai)
#pragma unroll
            for (int mp = 0; mp < 2; ++mp) {
                f32x4 xv[2][2][2];
#pragma unroll
                for (int mm = 0; mm < 2; ++mm)
#pragma unroll
                    for (int bj = 0; bj < 2; ++bj) { const unsigned eo = (unsigned)((ai * 128 + (mp * 2 + mm) * 16) * DM + bj * 128);
                        if constexpr (INBF) { const u32x4 w = *(const u32x4*)(xo + eo * 2u); xv[mm][bj][0] = (f32x4){bflo(w.x), bfhi(w.x), bflo(w.y), bfhi(w.y)}; xv[mm][bj][1] = (f32x4){bflo(w.z), bfhi(w.z), bflo(w.w), bfhi(w.w)}; }
                        else { xv[mm][bj][0] = *(const f32x4*)(xi + eo * 4u); xv[mm][bj][1] = *(const f32x4*)(xi + eo * 4u + 16u); } }
#pragma unroll
                for (int mm = 0; mm < 2; ++mm)
#pragma unroll
                    for (int bj = 0; bj < 2; ++bj) { const unsigned eo = (unsigned)((ai * 128 + (mp * 2 + mm) * 16) * DM + bj * 128);
                        const f32x4 y0 = xv[mm][bj][0] + gv[bj][0] * acc[ai][bj][mp * 2 + mm][0], y1 = xv[mm][bj][1] + gv[bj][1] * acc[ai][bj][mp * 2 + mm][1];
                        u32x4 w; w.x = cvtpk_v(y0[0], y0[1]); w.y = cvtpk_v(y0[2], y0[3]); w.z = cvtpk_v(y1[0], y1[1]); w.w = cvtpk_v(y1[2], y1[3]);
                        *(u32x4*)(xo + eo * 2u) = w; }
            }
    }
};
struct EpiScoresT {
    float* SC;
    DEV void operator()(const f32x4 (&acc)[2][2][4][2], const Unit& u, int wr, int wc, int fr, int fq) const {
#pragma unroll
        for (int bj = 0; bj < 2; ++bj)
#pragma unroll
            for (int n = 0; n < 2; ++n) {
                float* cp = SC + ((size_t)(u.pn * (TA / 64) + u.pm * 4 + wr) * 256 + bj * 128 + wc * 32 + n * 16 + fr) * 64 + fq * 4;
#pragma unroll
                for (int ai = 0; ai < 2; ++ai)
#pragma unroll
                    for (int m = 0; m < 4; ++m) *(f32x4*)(cp + ai * (2 * 256 * 64) + m * 16) = acc[ai][bj][m][n];
            }
    }
};
struct EpiMerge {
    bf16_t* M; const bf16_t* Z; const float* bg; float asc;
    DEV void operator()(const f32x4 (&acc)[2][2][4][2], const Unit& u, int wr, int wc, int fr, int fq) const {
        const int j0 = u.pn * 64 + wc * 16 + fq * 4;
        f32x4 bv[4];
#pragma unroll
        for (int nb = 0; nb < 4; ++nb) bv[nb] = *(const f32x4*)(bg + nb * 2048 + j0);
        const char* zb = (const char*)(Z + ((size_t)u.pm * 256 + wr * 64 + fr) * 8192 + j0); char* mb = (char*)(M + ((size_t)u.pm * 256 + wr * 64 + fr) * 2048 + j0);
        u32x2 zwn[4][4];
#pragma unroll
        for (int m = 0; m < 4; ++m)
#pragma unroll
            for (int nb = 0; nb < 4; ++nb) zwn[m][nb] = *(const u32x2*)(zb + (unsigned)(((m * 16) * 8192 + nb * 2048) * 2));
#pragma unroll
        for (int ai = 0; ai < 2; ++ai) {
            u32x2 zw[4][4];
#pragma unroll
            for (int m = 0; m < 4; ++m)
#pragma unroll
                for (int nb = 0; nb < 4; ++nb) { zw[m][nb] = zwn[m][nb]; if (ai == 0) zwn[m][nb] = *(const u32x2*)(zb + (unsigned)(((128 + m * 16) * 8192 + nb * 2048) * 2)); }
#pragma unroll
            for (int m = 0; m < 4; ++m) {
                f32x4 s = {0.f, 0.f, 0.f, 0.f};
#pragma unroll
                for (int nb = 0; nb < 4; ++nb) {
                    const f32x4 a = acc[ai][nb >> 1][m][nb & 1] * asc + bv[nb];
                    s[0] += sigmoidf_(a[0]) * bflo(zw[m][nb].x); s[1] += sigmoidf_(a[1]) * bfhi(zw[m][nb].x);
                    s[2] += sigmoidf_(a[2]) * bflo(zw[m][nb].y); s[3] += sigmoidf_(a[3]) * bfhi(zw[m][nb].y);
                }
                u32x2 w; w.x = cvtpk(s[0], s[1]); w.y = cvtpk(s[2], s[3]);
                *(u32x2*)(mb + (unsigned)((ai * 128 + m * 16) * 2048 * 2)) = w;
            }
        }
    }
};
struct EpiResid {
    const float *xin_l, *xin_c; float *xout_l, *xout_c; const float* gate;
    DEV void operator()(const f32x4 (&acc)[2][2][4][2], const Unit& u, int wr, int wc, int fr, int fq) const {
        const int brow = u.pm * 256, bcol = u.pn * 256;
        const bool isc = brow >= TL; const int r = isc ? 8 : (brow >> 11);
        const float* xi = isc ? xin_c - (long)TL * DM : xin_l; float* xo = isc ? xout_c - (long)TL * DM : xout_l;
        const float* g = gate + (long)r * 12288;
        f32x4 gv[2][2];
#pragma unroll
        for (int bj = 0; bj < 2; ++bj)
#pragma unroll
            for (int n = 0; n < 2; ++n) gv[bj][n] = *(const f32x4*)(g + bcol + bj * 128 + wc * 32 + n * 16 + fq * 4);
        const char* xib = (const char*)(xi + ((long)brow + wr * 64 + fr) * DM + bcol + wc * 32 + fq * 4); char* xob = (char*)(xo + ((long)brow + wr * 64 + fr) * DM + bcol + wc * 32 + fq * 4);
#pragma unroll
        for (int ai = 0; ai < 2; ++ai)
#pragma unroll
            for (int mp = 0; mp < 2; ++mp) {
                f32x4 xv[2][2][2];
#pragma unroll
                for (int mm = 0; mm < 2; ++mm)
#pragma unroll
                    for (int bj = 0; bj < 2; ++bj)
#pragma unroll
                        for (int n = 0; n < 2; ++n) xv[mm][bj][n] = *(const f32x4*)(xib + (unsigned)((((ai * 128 + (mp * 2 + mm) * 16) * DM) + bj * 128 + n * 16) * 4));
#pragma unroll
                for (int mm = 0; mm < 2; ++mm)
#pragma unroll
                    for (int bj = 0; bj < 2; ++bj)
#pragma unroll
                        for (int n = 0; n < 2; ++n)
                            *(f32x4*)(xob + (unsigned)((((ai * 128 + (mp * 2 + mm) * 16) * DM) + bj * 128 + n * 16) * 4)) = xv[mm][bj][n] + gv[bj][n] * acc[ai][bj][mp * 2 + mm][n];
            }
    }
};
}

DEV void cvt_tile_T(const float* __restrict__ src, long ld_src, int k0, int n0, bf16_t* __restrict__ dst, long ldd, long drow0  , int gperm  , float* tl) {
    const int tid = lid();
    {   const int kr = tid >> 4, nc = (tid & 15) * 4;
        f32x4 v[8];
#pragma unroll
        for (int h = 0; h < 8; ++h) v[h] = *(const f32x4*)(src + (long)(k0 + kr + 32 * h) * ld_src + n0 + nc);
#pragma unroll
        for (int h = 0; h < 8; ++h) { float* t = tl + (kr + 32 * h) * 65 + nc; t[0] = v[h][0]; t[1] = v[h][1]; t[2] = v[h][2]; t[3] = v[h][3]; }
    }
    __syncthreads();
    {   const int nr = tid >> 3, kc = (tid & 7) * 8;
        long drow;
        if (gperm < 0) drow = drow0 + nr;
        else drow = drow0 + (gperm >> 1) * 128 + (nr >> 4) * 32 + (gperm & 1) * 16 + (nr & 15);
#pragma unroll
        for (int j4 = 0; j4 < 4; ++j4) {
            float v[8];
#pragma unroll
            for (int j = 0; j < 8; ++j) v[j] = tl[(j4 * 64 + kc + j) * 65 + nr];
            if (gperm == -1) {
                u32x4 w; w.x = cvtpk(v[0], v[1]); w.y = cvtpk(v[2], v[3]); w.z = cvtpk(v[4], v[5]); w.w = cvtpk(v[6], v[7]);
                *(u32x4*)(dst + drow * ldd + k0 + j4 * 64 + kc) = w;
            } else {
#pragma unroll
                for (int j = 0; j < 8; ++j) v[j] = fminf(fmaxf(v[j] * 256.f, -448.f), 448.f);
                int d0 = 0, d1 = 0;
                d0 = __builtin_amdgcn_cvt_pk_fp8_f32(v[0], v[1], d0, false); d0 = __builtin_amdgcn_cvt_pk_fp8_f32(v[2], v[3], d0, true);
                d1 = __builtin_amdgcn_cvt_pk_fp8_f32(v[4], v[5], d1, false); d1 = __builtin_amdgcn_cvt_pk_fp8_f32(v[6], v[7], d1, true);
                u32x2 w; w.x = (unsigned)d0; w.y = (unsigned)d1;
                *(u32x2*)((unsigned char*)dst + drow * ldd + k0 + j4 * 64 + kc) = w;
            }
        }
    }
    __syncthreads();
}
DEV void cvt_matrix_T(const float* src, int K, int N, bf16_t* dst, float* tl, int bid, int nb, int& cursor, int mode = -1) {
    const int tk = K / 256, tn = N / 64, nt = tk * tn;
    int first = ((bid - cursor) % nb + nb) % nb;
    for (int u = first; u < nt; u += nb) { const int ik = u % tk, in_ = u / tk; cvt_tile_T(src, N, ik * 256, in_ * 64, dst, K, (long)in_ * 64, mode, tl); }
    cursor = (cursor + nt) % nb;
}
DEV void cvt_straight(const float* __restrict__ src, bf16_t* __restrict__ dst, long n8, int bid, int nb) {
    const int tix = lid();
    for (long i = (long)bid * 512 + tix; i < n8; i += (long)nb * 512) {
        const f32x4 a = *(const f32x4*)(src + i * 8), b = *(const f32x4*)(src + i * 8 + 4);
        u32x4 w; w.x = cvtpk(a[0], a[1]); w.y = cvtpk(a[2], a[3]); w.z = cvtpk(b[0], b[1]); w.w = cvtpk(b[2], b[3]);
        *(u32x4*)(dst + i * 8) = w;
    }
}

DEV unsigned pack_i8x4(float a, float b, float c, float d) {
    const unsigned m0 = __float_as_uint(a + 12582912.f), m1 = __float_as_uint(b + 12582912.f), m2 = __float_as_uint(c + 12582912.f), m3 = __float_as_uint(d + 12582912.f);
    return __builtin_amdgcn_perm(m1, m0, 0x0c0c0400u) | __builtin_amdgcn_perm(m3, m2, 0x04000c0cu);
}
DEV void cvt_rows_ld(const float* __restrict__ src, int row0, int lane, f32x4 (&v)[2][8]) {
#pragma unroll
    for (int rr = 0; rr < 2; ++rr) { const float* sr = src + (size_t)(row0 + rr) * DM + lane * 16;
#pragma unroll
        for (int c = 0; c < 2; ++c)
#pragma unroll
            for (int k = 0; k < 4; ++k) v[rr][c * 4 + k] = *(const f32x4*)(sr + c * 1024 + k * 4); }
}
DEV void cvt_expert_tables(const P& p, int bid, int nb) {
    const int tix = lid(); const int wid = tix >> 6, lane = tix & 63;
    const int per = (8192 + nb * 8 - 1) / (nb * 8), nit = 4 * per;
    f32x4 v[2][8], vn[2][8];
    int it = 0, rp = bid * 8 + wid;
    while (it < nit && rp >= 8192) { ++it; rp = (bid * 8 + wid) + (it % per) * nb * 8; }
    if (it < nit) { const int tb = it / per; cvt_rows_ld((tb & 1 ? p.peer_v : p.peer_u) + (size_t)(tb >> 1) * 16384 * DM, rp * 2, lane, v); }
#pragma unroll 1
    while (it < nit) {
        int itn = it + 1, rpn = (bid * 8 + wid) + (itn % per) * nb * 8;
        while (itn < nit && rpn >= 8192) { ++itn; rpn = (bid * 8 + wid) + (itn % per) * nb * 8; }
        if (itn < nit) { const int tbn = itn / per; cvt_rows_ld((tbn & 1 ? p.peer_v : p.peer_u) + (size_t)(tbn >> 1) * 16384 * DM, rpn * 2, lane, vn); }
        const int tb = it / per, l = tb >> 1; const bool i8 = !(tb & 1); const int row0 = rp * 2;
        unsigned char* dst = (unsigned char*)wl(p, l, i8 ? W_U : W_V); float* descale = (float*)wl(p, l, i8 ? W_US : W_VS);
#pragma unroll
        for (int rr = 0; rr < 2; ++rr) {
            float am = 0.f;
#pragma unroll
            for (int q = 0; q < 8; ++q) am = fmaxf(am, fmaxf(fmaxf(fabsf(v[rr][q][0]), fabsf(v[rr][q][1])), fmaxf(fabsf(v[rr][q][2]), fabsf(v[rr][q][3]))));
            am = fmaxf(am, xshf<1>(am)); am = fmaxf(am, xshf<2>(am)); am = fmaxf(am, xshf<4>(am)); am = fmaxf(am, xshf<8>(am)); am = fmaxf(am, xshf<16>(am)); am = fmaxf(am, xshf<32>(am));
            const float top = i8 ? 127.f : 6.f;
            const float sc = am > 0.f ? top / am : 1.f;
#pragma unroll
            for (int c = 0; c < 2; ++c) {
                if (i8) { u32x4 w;
#pragma unroll
                    for (int k = 0; k < 4; ++k) { const f32x4 a = v[rr][c * 4 + k] * sc; w[k] = pack_i8x4(a[0], a[1], a[2], a[3]); }
                    *(u32x4*)(dst + (size_t)(c * 8 + (lane >> 3)) * (16384 * 128) + (size_t)(row0 + rr) * 128 + (lane & 7) * 16) = w;
                } else { u32x2 w = {0u, 0u};
                    { const f32x4 a0 = v[rr][c * 4] * sc, a1 = v[rr][c * 4 + 1] * sc, a2 = v[rr][c * 4 + 2] * sc, a3 = v[rr][c * 4 + 3] * sc;
                      w.x = __builtin_amdgcn_cvt_scalef32_pk_fp4_f32(w.x, a0[0], a0[1], 1.0f, 0); w.x = __builtin_amdgcn_cvt_scalef32_pk_fp4_f32(w.x, a0[2], a0[3], 1.0f, 1);
                      w.x = __builtin_amdgcn_cvt_scalef32_pk_fp4_f32(w.x, a1[0], a1[1], 1.0f, 2); w.x = __builtin_amdgcn_cvt_scalef32_pk_fp4_f32(w.x, a1[2], a1[3], 1.0f, 3);
                      w.y = __builtin_amdgcn_cvt_scalef32_pk_fp4_f32(w.y, a2[0], a2[1], 1.0f, 0); w.y = __builtin_amdgcn_cvt_scalef32_pk_fp4_f32(w.y, a2[2], a2[3], 1.0f, 1);
                      w.y = __builtin_amdgcn_cvt_scalef32_pk_fp4_f32(w.y, a3[0], a3[1], 1.0f, 2); w.y = __builtin_amdgcn_cvt_scalef32_pk_fp4_f32(w.y, a3[2], a3[3], 1.0f, 3); }
                    *(u32x2*)(dst + (size_t)(c * 4 + (lane >> 4)) * (16384 * 128) + (size_t)(row0 + rr) * 128 + (lane & 15) * 8) = w; }
            }
            if (lane == 0) descale[row0 + rr] = am > 0.f ? am / top : 1.f;
        }
#pragma unroll
        for (int rr = 0; rr < 2; ++rr)
#pragma unroll
            for (int q = 0; q < 8; ++q) v[rr][q] = vn[rr][q];
        it = itn; rp = rpn;
    }
}
DEV bf16x8 ld8f(const float* p_) { const f32x4 a = *(const f32x4*)p_, b = *(const f32x4*)(p_ + 4); u32x4 w = {cvtpk(a[0], a[1]), cvtpk(a[2], a[3]), cvtpk(b[0], b[1]), cvtpk(b[2], b[3])}; return *reinterpret_cast<bf16x8*>(&w); }
DEV void fold_subkeys(const float* __restrict__ sk, const float* __restrict__ wq, bf16_t* __restrict__ out, int bid, int nb) {
    const int tix = lid(); const int wid = tix >> 6, lane = tix & 63, r32 = lane & 31, hi = lane >> 5;
    for (int task = bid * 8 + wid; task < 16 * 64; task += nb * 8) {
        const int hs = task >> 6, ib = task & 63;
        bf16x8 bw[8];
#pragma unroll
        for (int ks = 0; ks < 8; ++ks) bw[ks] = ld8f(wq + (size_t)(ib * 32 + r32) * DM + hs * 128 + ks * 16 + hi * 8);
#pragma unroll
        for (int kb = 0; kb < 4; ++kb) {
            f32x16 acc = {};
#pragma unroll
            for (int ks = 0; ks < 8; ++ks) acc = __builtin_amdgcn_mfma_f32_32x32x16_bf16(ld8f(sk + (size_t)(hs * 128 + kb * 32 + r32) * 128 + ks * 16 + hi * 8), bw[ks], acc, 0, 0, 0);
#pragma unroll
            for (int rr = 0; rr < 16; ++rr) out[(size_t)(hs * 128 + kb * 32 + at_crow(rr, hi)) * DM + ib * 32 + r32] = (bf16_t)(cvtpk_v(acc[rr], acc[rr]) & 0xffffu);
        }
    }
}
struct TileD { const float* src; int ld_src, k0, n0; bf16_t* dst; int ldd, drow0, mode; };
constexpr int T_IN = 8 * 93, T_G = 4 * 8 * 32, T_B = 4 * 2 * 32, T_O = 8 * 32, T_UQ = 2 * 12, T_UKV = 1 * 16, T_INB = PROJ_BF16_TILES ? T_IN : 0;
constexpr int T_LAYER = T_IN + T_G + T_B + T_O + T_UQ + T_UKV + T_INB;
DEV TileD tile_desc(const P& p, int g) {
    const int l = g / T_LAYER; int r = g % T_LAYER; TileD d;
    if (r < T_IN) { d.src = p.w_in + (size_t)l * DM * INW; d.ld_src = INW; d.k0 = (r % 8) * 256; d.n0 = (r / 8) * 64; d.dst = wl(p, l, W_IN8); d.ldd = DM; d.drow0 = (r / 8) * 64; d.mode = -3; return d; }
    r -= T_IN;
    if (r < T_G) { const int gg = r >> 8, q = r & 255; d.src = p.w_gate + ((size_t)l * 4 + gg) * DM * DM; d.ld_src = DM; d.k0 = (q & 7) * 256; d.n0 = (q >> 3) * 64; d.dst = wl(p, l, W_G); d.ldd = DM; d.drow0 = (q >> 3) * 256; d.mode = gg; return d; }
    r -= T_G;
    if (r < T_B) { const int gg = r >> 6, q = r & 63; d.src = p.w_branch + ((size_t)l * 4 + gg) * 512 * DM; d.ld_src = DM; d.k0 = (q & 1) * 256; d.n0 = (q >> 1) * 64; d.dst = wl(p, l, W_B) + (size_t)gg * DM * 512; d.ldd = 512; d.drow0 = (q >> 1) * 64; d.mode = -1; return d; }
    r -= T_B;
    if (r < T_O) { d.src = p.w_o + (size_t)l * DM * DM; d.ld_src = DM; d.k0 = (r & 7) * 256; d.n0 = (r >> 3) * 64; d.dst = wl(p, l, W_O); d.ldd = DM; d.drow0 = (r >> 3) * 64; d.mode = -1; return d; }
    r -= T_O;
    if (r < T_UQ) { d.src = p.w_uq + (size_t)l * 512 * 768; d.ld_src = 768; d.k0 = (r & 1) * 256; d.n0 = (r >> 1) * 64; d.dst = wl(p, l, W_UQ); d.ldd = 512; d.drow0 = (r >> 1) * 64; d.mode = -1; return d; }
    r -= T_UQ;
    if (r < T_UKV) { d.src = p.w_ukv + (size_t)l * 256 * 1024; d.ld_src = 1024; d.k0 = 0; d.n0 = r * 64; d.dst = wl(p, l, W_UKV); d.ldd = 256; d.drow0 = r * 64; d.mode = -1; return d; }
    r -= T_UKV;
    d.src = p.w_in + (size_t)l * DM * INW; d.ld_src = INW; d.k0 = (r % 8) * 256; d.n0 = (r / 8) * 64; d.dst = wl(p, l, W_IN); d.ldd = DM; d.drow0 = (r / 8) * 64; d.mode = -1; return d;
}
DEV void phase_prologue(const P& p, char* smem, int bid, int nb) {
    const int tix = lid();
    float* tl = (float*)smem;
    {
        const int kr = tix >> 4, nc = (tix & 15) * 4, nr = tix >> 3, kc = (tix & 7) * 8;
        int g = bid; f32x4 v[8]; TileD d;
        if (g < 2 * T_LAYER) { d = tile_desc(p, g);
#pragma unroll
            for (int h = 0; h < 8; ++h) v[h] = *(const f32x4*)(d.src + (size_t)(d.k0 + kr + 32 * h) * d.ld_src + d.n0 + nc); }
#pragma unroll 1
        while (g < 2 * T_LAYER) {
#pragma unroll
            for (int h = 0; h < 8; ++h) { float* t = tl + (kr + 32 * h) * 65 + nc; t[0] = v[h][0]; t[1] = v[h][1]; t[2] = v[h][2]; t[3] = v[h][3]; }
            __syncthreads();
            const int gn = g + nb; TileD dn = d;
            if (gn < 2 * T_LAYER) { dn = tile_desc(p, gn);
#pragma unroll
                for (int h = 0; h < 8; ++h) v[h] = *(const f32x4*)(dn.src + (size_t)(dn.k0 + kr + 32 * h) * dn.ld_src + dn.n0 + nc); }
            long drow;
            if (d.mode == -3) { const int n_ = d.drow0 + nr, c = n_ & 31; drow = (n_ & ~31) + 16 * ((c >> 2) & 1) + 4 * (c >> 3) + (c & 3); }
            else if (d.mode < 0) drow = d.drow0 + nr;
            else drow = d.drow0 + (d.mode >> 1) * 128 + (nr >> 4) * 32 + (d.mode & 1) * 16 + (nr & 15);
#pragma unroll
            for (int j4 = 0; j4 < 4; ++j4) {
                float w8[8];
#pragma unroll
                for (int j = 0; j < 8; ++j) w8[j] = tl[(j4 * 64 + kc + j) * 65 + nr];
                if (d.mode == -1) {
                    u32x4 w; w.x = cvtpk(w8[0], w8[1]); w.y = cvtpk(w8[2], w8[3]); w.z = cvtpk(w8[4], w8[5]); w.w = cvtpk(w8[6], w8[7]);
                    *(u32x4*)(d.dst + drow * d.ldd + d.k0 + j4 * 64 + kc) = w;
                } else {
#pragma unroll
                    for (int j = 0; j < 8; ++j) w8[j] = fminf(fmaxf(w8[j] * 256.f, -448.f), 448.f);
                    int d0 = 0, d1 = 0;
                    d0 = __builtin_amdgcn_cvt_pk_fp8_f32(w8[0], w8[1], d0, false); d0 = __builtin_amdgcn_cvt_pk_fp8_f32(w8[2], w8[3], d0, true);
                    d1 = __builtin_amdgcn_cvt_pk_fp8_f32(w8[4], w8[5], d1, false); d1 = __builtin_amdgcn_cvt_pk_fp8_f32(w8[6], w8[7], d1, true);
                    u32x2 w; w.x = (unsigned)d0; w.y = (unsigned)d1;
                    *(u32x2*)((unsigned char*)d.dst + drow * d.ldd + d.k0 + j4 * 64 + kc) = w;
                }
            }
            __syncthreads();
            g = gn; d = dn;
        }
    }
    for (int l = 0; l < 2; ++l) {
        { unsigned char* d = (unsigned char*)wl(p, l, W_IN8) + (size_t)INW * DM; const long n16 = (long)(INP - INW) * DM / 16;
          for (long i = (long)bid * 512 + tix; i < n16; i += (long)nb * 512) *(u32x4*)(d + i * 16) = (u32x4){0u, 0u, 0u, 0u}; }
        if (PROJ_BF16_TILES) { bf16_t* d = wl(p, l, W_IN) + (size_t)INW * DM; const long n8 = (long)(INP - INW) * DM / 8;
          for (long i = (long)bid * 512 + tix; i < n8; i += (long)nb * 512) *(u32x4*)(d + i * 8) = (u32x4){0u, 0u, 0u, 0u}; }
        fold_subkeys(p.peer_sub_keys + (size_t)l * 262144, p.peer_w_query + (size_t)l * DM * DM, wl(p, l, W_Q), bid, nb);
    }
    cvt_expert_tables(p, bid, nb);
    {
        float* sl = (float*)smem;
        float* red = sl + 9 * 2048;
        const int wid = tix >> 6, lane = tix & 63;
        __syncthreads();
        for (int e = tix; e < 9 * 2048; e += 512) { const int r = e >> 11, i = e & 2047; sl[e] = siluf_(r < 8 ? p.c[r * DM + i] : p.c_ctx[i]); }
        __syncthreads();
        for (int u = bid; u < 256; u += nb) {
            const int l = u >> 7, j = (u & 127) * 96 + lane * 2; const bool act = lane < 48;
            const float* w = p.w_mod + (size_t)l * DM * 12288 + j;
            f32x2 a[9];
#pragma unroll
            for (int r = 0; r < 9; ++r) a[r] = (f32x2){0.f, 0.f};
#pragma unroll 1
            for (int i0 = wid * 256; i0 < wid * 256 + 256; i0 += 32) {
                f32x2 wv[32];
#pragma unroll
                for (int q = 0; q < 32; ++q) wv[q] = act ? *(const f32x2*)(w + (size_t)(i0 + q) * 12288) : (f32x2){0.f, 0.f};
#pragma unroll
                for (int q4 = 0; q4 < 8; ++q4) {
#pragma unroll
                    for (int r = 0; r < 9; ++r) { const f32x4 sv = *(const f32x4*)(sl + r * 2048 + i0 + q4 * 4);
#pragma unroll
                        for (int e = 0; e < 4; ++e) { a[r][0] += sv[e] * wv[q4 * 4 + e][0]; a[r][1] += sv[e] * wv[q4 * 4 + e][1]; } }
                }
            }
            __syncthreads();
            if (act) {
#pragma unroll
                for (int r = 0; r < 9; ++r) { red[(wid * 9 + r) * 96 + lane * 2] = a[r][0]; red[(wid * 9 + r) * 96 + lane * 2 + 1] = a[r][1]; } }
            __syncthreads();
            for (int e = tix; e < 9 * 96; e += 512) {
                const int r = e / 96, jj = e % 96; float sacc = 0.f;
#pragma unroll
                for (int w8 = 0; w8 < 8; ++w8) sacc += red[(w8 * 9 + r) * 96 + jj];
                const int jg = (u & 127) * 96 + jj;
                wsf(p, OFF_MOD)[((size_t)l * 9 + r) * 12288 + jg] = sacc + p.b_mod[(size_t)l * 12288 + jg];
            }
        }
    }
    if (bid == 0) {
        float* ra = wsf(p, OFF_ROPEA); float* rr = wsf(p, OFF_ROPER); float* misc = wsf(p, OFF_MISC);
        for (int e = tix; e < 64 * 16; e += 512) { const int pos = e >> 4, i = e & 15; const float inv = exp2f(-(float)i / 16.f * 13.287712379549449f);
            float s, c; sincosf((float)pos * inv, &s, &c); ra[e] = c; ra[1024 + e] = s; }
        for (int e = tix; e < 64 * 32; e += 512) { const int pos = e >> 5, i = e & 31; const float inv = exp2f(-(float)i / 32.f * 13.287712379549449f);
            float s, c; sincosf((float)pos * inv, &s, &c); rr[e] = c; rr[2048 + e] = s; }
        if (tix < 128) {
            const int l = tix >> 6, i = tix & 63; const float* dl = p.diff_lambda + l * 256;
            const float s01 = wave_sum(dl[i] * dl[64 + i]), s23 = wave_sum(dl[128 + i] * dl[192 + i]);
            const float lam_init = 0.8f - 0.6f * expf(-0.3f * (float)l);
            if (i == 0) { misc[l * 2] = expf(s01) - expf(s23) + lam_init; misc[l * 2 + 1] = lam_init; }
        }
        if (tix < 16) {
            const float x = p.ret_decay[tix]; misc[8 + tix] = -log1pf(expf(-x)) * 1.4426950408889634f;
        }
    }
}

DEV void phase_norm(const float* xl, const float* xc, const float* g, const float* mod  , int shi, int sci, bf16_t* H, int nrows, int bid, int nb, unsigned char* H8 = nullptr, unsigned char* HI8 = nullptr, float* HSC = nullptr, const bf16_t* xb = nullptr  ) {
    const int tix = lid(); const int wid = tix >> 6, lane = tix & 63;
    for (int row = bid * 8 + wid; row < nrows; row += nb * 8) {
        const float* src = row < TL ? xl + (size_t)row * DM : xc + (size_t)(row - TL) * DM;
        const int r = row < TL ? (row >> 11) : 8;
        const float* sh = mod + (size_t)r * 12288 + shi * DM; const float* sc = mod + (size_t)r * 12288 + sci * DM;
        f32x4 v[8]; float ss = 0.f;
        if (xb) { u32x2 w[8];
#pragma unroll
            for (int c = 0; c < 8; ++c) w[c] = *(const u32x2*)(xb + (size_t)row * DM + c * 256 + lane * 4);
#pragma unroll
            for (int c = 0; c < 8; ++c) v[c] = (f32x4){bflo(w[c].x), bfhi(w[c].x), bflo(w[c].y), bfhi(w[c].y)};
        } else {
#pragma unroll
            for (int c = 0; c < 8; ++c) v[c] = *(const f32x4*)(src + c * 256 + lane * 4); }
#pragma unroll
        for (int c = 0; c < 8; ++c) ss += v[c][0] * v[c][0] + v[c][1] * v[c][1] + v[c][2] * v[c][2] + v[c][3] * v[c][3];
        ss = wave_sum(ss);
        const float rs = rsqrtf(ss * (1.f / DM) + EPS);
        float am = 0.f;
#pragma unroll
        for (int c = 0; c < 8; ++c) {
            const int i = c * 256 + lane * 4;
            const f32x4 gv = *(const f32x4*)(g + i), sv = *(const f32x4*)(sc + i), hv = *(const f32x4*)(sh + i);
            f32x4 y;
#pragma unroll
            for (int q = 0; q < 4; ++q) y[q] = (v[c][q] * rs * gv[q]) * (1.f + sv[q]) + hv[q];
            if (H) { u32x2 w; w.x = cvtpk(y[0], y[1]); w.y = cvtpk(y[2], y[3]); *(u32x2*)(H + (size_t)row * DM + i) = w; }
            if (HI8) { v[c] = y; am = fmaxf(am, fmaxf(fmaxf(fabsf(y[0]), fabsf(y[1])), fmaxf(fabsf(y[2]), fabsf(y[3])))); }
            if (H8) {
#pragma unroll
                for (int q = 0; q < 4; ++q) y[q] = fminf(fmaxf(y[q], -448.f), 448.f);
                int d = 0; d = __builtin_amdgcn_cvt_pk_fp8_f32(y[0], y[1], d, false); d = __builtin_amdgcn_cvt_pk_fp8_f32(y[2], y[3], d, true);
                *(unsigned*)(H8 + (size_t)row * DM + i) = (unsigned)d;
            }
        }
        if (HI8) {
            am = fmaxf(am, xshf<1>(am)); am = fmaxf(am, xshf<2>(am)); am = fmaxf(am, xshf<4>(am)); am = fmaxf(am, xshf<8>(am)); am = fmaxf(am, xshf<16>(am)); am = fmaxf(am, xshf<32>(am));
            const float qs = am > 0.f ? 127.f / am : 1.f;
#pragma unroll
            for (int c = 0; c < 8; ++c) *(unsigned*)(HI8 + (size_t)row * DM + c * 256 + lane * 4) = pack_i8x4(v[c][0] * qs, v[c][1] * qs, v[c][2] * qs, v[c][3] * qs);
            if (lane == 0) HSC[row] = am > 0.f ? am * (1.f / 127.f) : 1.f;
        }
    }
}

DEV void unpack8(const u32x4 w, float (&v)[8]) { v[0] = bflo(w.x); v[1] = bfhi(w.x); v[2] = bflo(w.y); v[3] = bfhi(w.y); v[4] = bflo(w.z); v[5] = bfhi(w.z); v[6] = bflo(w.w); v[7] = bfhi(w.w); }
DEV u32x4 pack8(const float (&v)[8]) { u32x4 o; o.x = cvtpk(v[0], v[1]); o.y = cvtpk(v[2], v[3]); o.z = cvtpk(v[4], v[5]); o.w = cvtpk(v[6], v[7]); return o; }
DEV float sumsq8(const float (&v)[8]) { float s = 0.f;
#pragma unroll
    for (int q = 0; q < 8; ++q) s += v[q] * v[q];
    return s; }
template <int PM, int SOFF> DEV void rope8(float (&v)[8], const float* tab, bool hiq) {
    const f32x4 c0 = *(const f32x4*)tab, c1 = *(const f32x4*)(tab + 4), s0 = *(const f32x4*)(tab + SOFF), s1 = *(const f32x4*)(tab + SOFF + 4);
#pragma unroll
    for (int q = 0; q < 8; ++q) { const float pt = xshf<PM>(v[q]); const float cs = q < 4 ? c0[q & 3] : c1[q & 3], sn = q < 4 ? s0[q & 3] : s1[q & 3];
        v[q] = v[q] * cs + (hiq ? pt : -pt) * sn; }
}
struct Prep1Row { u32x4 a[7]; u32x2 b; };
DEV void prep1_load(const bf16_t* pr, int lane, bool lat, Prep1Row& R) {
    R.a[0] = *(const u32x4*)(pr + C_DAQ + lane * 8); R.a[1] = *(const u32x4*)(pr + C_DAK + lane * 8);
    R.a[2] = lat ? *(const u32x4*)(pr + C_RTQ + lane * 8) : (u32x4){0u, 0u, 0u, 0u}; R.a[3] = *(const u32x4*)(pr + C_RTK + lane * 8);
    R.a[4] = *(const u32x4*)(pr + C_NAQ + lane * 8); R.a[5] = *(const u32x4*)(pr + C_NAK + lane * 8);
    R.a[6] = *(const u32x4*)(pr + C_MCQ + lane * 8); R.b = *(const u32x2*)(pr + C_MKV + lane * 4);
}
DEV void phase_prep1(const P& p, int l, int bid, int nb) {
    const int tix = lid(); const int wid = tix >> 6, lane = tix & 63;
    const float* ra = wsf(p, OFF_ROPEA); const float* rr = wsf(p, OFF_ROPER);
    const float* dag = p.diff_qk_g + l * 128; const float* nag = p.na_qk_g + l * 128;
    int row = bid * 8 + wid;
    Prep1Row cur, nxt;
    if (row < TA) prep1_load(wsb(p, OFF_PROJ) + (size_t)row * INP, lane, row < TL, cur);
#pragma unroll 1
    for (; row < TA; row += nb * 8) {
        const int nrow = row + nb * 8;
        if (nrow < TA) prep1_load(wsb(p, OFF_PROJ) + (size_t)nrow * INP, lane, nrow < TL, nxt);
        bf16_t* pr = wsb(p, OFF_PROJ) + (size_t)row * INP;
        const bool lat = row < TL; const int s = row & 2047, gr = s >> 6, gc = s & 63;
        { const int ci = lane & 7;
#pragma unroll
          for (int it = 0; it < 2; ++it) {
            u32x4* e = (u32x4*)(pr + (it ? C_DAK : C_DAQ) + lane * 8); float v[8]; unpack8(cur.a[it], v);
            float ss = sumsq8(v); ss += xshf<1>(ss); ss += xshf<2>(ss); ss += xshf<4>(ss);
            const float rs = rsqrtf(ss * (1.f / 64.f) + EPS); const float* g = dag + it * 64 + ci * 8;
#pragma unroll
            for (int q = 0; q < 8; ++q) v[q] = v[q] * rs * g[q];
            if (lat) rope8<2, 1024>(v, ra + (ci < 4 ? gr : gc) * 16 + (ci & 1) * 8, (ci & 2) != 0);
            *e = pack8(v);
          } }
        { const int ci = lane & 15;
#pragma unroll
          for (int it = 0; it < 2; ++it) {
            if (it == 0 && !lat) continue;
            u32x4* e = (u32x4*)(pr + (it ? C_RTK : C_RTQ) + lane * 8); float v[8]; unpack8(cur.a[2 + it], v);
            if (it) {
#pragma unroll
                for (int q = 0; q < 8; ++q) v[q] *= 0.08838834764831845f; }
            if (lat) rope8<4, 2048>(v, rr + (ci < 8 ? gr : gc) * 32 + (ci & 3) * 8, (ci & 4) != 0);
            *e = pack8(v);
          } }
        { const int ci = lane & 7;
#pragma unroll
          for (int it = 0; it < 2; ++it) {
            u32x4* e = (u32x4*)(pr + (it ? C_NAK : C_NAQ) + lane * 8); float v[8]; unpack8(cur.a[4 + it], v);
            float ss = sumsq8(v); ss += xshf<1>(ss); ss += xshf<2>(ss); ss += xshf<4>(ss);
            const float rs = rsqrtf(ss * (1.f / 64.f) + EPS); const float* g = nag + it * 64 + ci * 8;
#pragma unroll
            for (int q = 0; q < 8; ++q) v[q] = v[q] * rs * g[q];
            *e = pack8(v);
          } }
        {
            u32x4* e = (u32x4*)(pr + C_MCQ + lane * 8); float v[8]; unpack8(cur.a[6], v);
            const float rs = rsqrtf(wave_sum(sumsq8(v)) * (1.f / 512.f) + EPS);
            const float* g = p.mla_q_norm_g + l * 512 + lane * 8;
#pragma unroll
            for (int q = 0; q < 8; ++q) v[q] = v[q] * rs * g[q];
            *e = pack8(v);
        }
        {
            u32x2* e = (u32x2*)(pr + C_MKV + lane * 4); const u32x2 w = cur.b;
            float v[4] = {bflo(w.x), bfhi(w.x), bflo(w.y), bfhi(w.y)};
            float ss = v[0] * v[0] + v[1] * v[1] + v[2] * v[2] + v[3] * v[3];
            ss = wave_sum(ss); const float rs = rsqrtf(ss * (1.f / 256.f) + EPS);
            const float* g = p.mla_kv_norm_g + l * 256 + lane * 4;
#pragma unroll
            for (int q = 0; q < 4; ++q) v[q] = v[q] * rs * g[q];
            u32x2 o; o.x = cvtpk(v[0], v[1]); o.y = cvtpk(v[2], v[3]); *e = o;
        }
#pragma unroll
        for (int q = 0; q < 7; ++q) cur.a[q] = nxt.a[q];
        cur.b = nxt.b;
    }
}

DEV void prep2_load(const P& p, int row, int ci, int hsel, bool act, u32x4 (&w)[2][2]) {
    const bf16_t* qm = wsb(p, OFF_QM) + (size_t)row * 768; const bf16_t* kv = wsb(p, OFF_KVM) + (size_t)row * 1024; const bf16_t* kr = wsb(p, OFF_PROJ) + (size_t)row * INP + C_MKR;
#pragma unroll
    for (int hp = 0; hp < 2; ++hp) { const int h = hp * 2 + hsel;
        w[hp][0] = (u32x4){0u, 0u, 0u, 0u}; w[hp][1] = (u32x4){0u, 0u, 0u, 0u};
        if (act) { w[hp][0] = *(const u32x4*)(qm + h * 192 + ci * 8); w[hp][1] = ci < 16 ? *(const u32x4*)(kv + h * 256 + ci * 8) : *(const u32x4*)(kr + (ci - 16) * 8); } }
}
DEV void phase_prep2(const P& p, int l, int bid, int nb) {
    const int tix = lid(); const int wid = tix >> 6, lane = tix & 63;
    const float* ra = wsf(p, OFF_ROPEA);
    const float* gq = p.mla_qk_g + l * 384; const float* gk = gq + 192;
    const int ci = lane & 31, hsel = lane >> 5; const bool act = ci < 24; const int cr = ci - 16;
    int row = bid * 8 + wid;
    u32x4 cur[2][2], nxt[2][2];
    if (row < TA) prep2_load(p, row, ci, hsel, act, cur);
#pragma unroll 1
    for (; row < TA; row += nb * 8) {
        const int nrow = row + nb * 8;
        if (nrow < TA) prep2_load(p, nrow, ci, hsel, act, nxt);
        const bool lat = row < TL; const int s = row & 2047, gr = s >> 6, gc = s & 63;
        bf16_t* qm = wsb(p, OFF_QM) + (size_t)row * 768; bf16_t* km = wsb(p, OFF_KM) + (size_t)row * 768;
        const float* rtab = ra + ((cr & 7) < 4 ? gr : gc) * 16 + (cr & 1) * 8;
#pragma unroll
        for (int hp = 0; hp < 2; ++hp) {
            const int h = hp * 2 + hsel;
            {   float v[8]; unpack8(cur[hp][0], v);
                float ss = sumsq8(v); ss += xshf<1>(ss); ss += xshf<2>(ss); ss += xshf<4>(ss); ss += xshf<8>(ss); ss += xshf<16>(ss);
                const float rs = rsqrtf(ss * (1.f / 192.f) + EPS); const float* g = gq + (act ? ci : 0) * 8;
#pragma unroll
                for (int q = 0; q < 8; ++q) v[q] = v[q] * rs * g[q];
                if (lat) { float r8[8];
#pragma unroll
                    for (int q = 0; q < 8; ++q) r8[q] = v[q];
                    rope8<2, 1024>(r8, rtab, (cr & 2) != 0);
                    if (ci >= 16) {
#pragma unroll
                        for (int q = 0; q < 8; ++q) v[q] = r8[q]; } }
                if (act) *(u32x4*)(qm + h * 192 + ci * 8) = pack8(v); }
            {   float v[8]; unpack8(cur[hp][1], v);
                float ss = sumsq8(v); ss += xshf<1>(ss); ss += xshf<2>(ss); ss += xshf<4>(ss); ss += xshf<8>(ss); ss += xshf<16>(ss);
                const float rs = rsqrtf(ss * (1.f / 192.f) + EPS); const float* g = gk + (act ? ci : 0) * 8;
#pragma unroll
                for (int q = 0; q < 8; ++q) v[q] = v[q] * rs * g[q];
                if (lat) { float r8[8];
#pragma unroll
                    for (int q = 0; q < 8; ++q) r8[q] = v[q];
                    rope8<2, 1024>(r8, rtab, (cr & 2) != 0);
                    if (ci >= 16) {
#pragma unroll
                        for (int q = 0; q < 8; ++q) v[q] = r8[q]; } }
                if (act) *(u32x4*)(km + h * 192 + ci * 8) = pack8(v); }
        }
#pragma unroll
        for (int hp = 0; hp < 2; ++hp) { cur[hp][0] = nxt[hp][0]; cur[hp][1] = nxt[hp][1]; }
    }
}

namespace at {
#define SBAR() __builtin_amdgcn_sched_barrier(0)
constexpr float THR = 8.f;
DEV int crow(int r, int hi) { return (r & 3) + 8 * (r >> 2) + 4 * hi; }
template <int N> DEV void wait_vm() { asm volatile("s_waitcnt vmcnt(%0)" ::"n"(N) : "memory"); }
template <int KSW> DEV int kaddr(int row, int ch) {
    if (KSW == 0) return row * 256 + ((ch ^ (row & 15)) << 4);
    if (KSW == 1) return row * 384 + ((ch ^ ((row >> 1) & 7)) << 4);
    return row * 512 + ((ch ^ (row & 15)) << 4);
}
DEV void partialSM(f32x16& p0, f32x16& p1, float& m_reg, float& mn, float& alpha, float C, float thr_raw) {
    float pmax = p0[0];
#pragma unroll
    for (int r = 1; r < 16; ++r) pmax = fmaxf(pmax, p0[r]);
#pragma unroll
    for (int r = 0; r < 16; ++r) pmax = fmaxf(pmax, p1[r]);
    { auto rr = __builtin_amdgcn_permlane32_swap(__float_as_uint(pmax), __float_as_uint(pmax), false, false);
      pmax = fmaxf(__uint_as_float(rr[0]), __uint_as_float(rr[1])); }
    if (__builtin_expect(__all(pmax - m_reg <= thr_raw), 1)) { mn = m_reg; alpha = 1.f; }
    else { mn = fmaxf(m_reg, pmax); alpha = __builtin_amdgcn_exp2f((m_reg - mn) * C); m_reg = mn; }
    const float mnC = -mn * C;
#pragma unroll
    for (int r = 0; r < 16; ++r) p0[r] = fmaf(p0[r], C, mnC);
#pragma unroll
    for (int r = 0; r < 16; ++r) p1[r] = fmaf(p1[r], C, mnC);
#pragma unroll
    for (int r = 0; r < 16; ++r) p0[r] = __builtin_amdgcn_exp2f(p0[r]);
}
DEV void finishSM(f32x16& p0, f32x16& p1, float alpha, float& l_reg, bf16x8& pa0, bf16x8& pa1, bf16x8& pa2, bf16x8& pa3) {
#pragma unroll
    for (int r = 0; r < 16; ++r) p1[r] = __builtin_amdgcn_exp2f(p1[r]);
    float ps = 0;
#pragma unroll
    for (int r = 0; r < 16; ++r) ps += p0[r];
#pragma unroll
    for (int r = 0; r < 16; ++r) ps += p1[r];
    { auto rr = __builtin_amdgcn_permlane32_swap(__float_as_uint(ps), __float_as_uint(ps), false, false);
      ps = __uint_as_float(rr[0]) + __uint_as_float(rr[1]); }
    l_reg = l_reg * alpha + ps;
#define PK4(Pq, BASE, OUT) do { unsigned a0 = cvtpk(Pq[BASE + 0], Pq[BASE + 1]), a1 = cvtpk(Pq[BASE + 2], Pq[BASE + 3]);   \
    unsigned b0 = cvtpk(Pq[BASE + 4], Pq[BASE + 5]), b1 = cvtpk(Pq[BASE + 6], Pq[BASE + 7]);                              \
    auto r0 = __builtin_amdgcn_permlane32_swap(a0, b0, false, false); auto r1 = __builtin_amdgcn_permlane32_swap(a1, b1, false, false); \
    u32x4 w = {r0[0], r1[0], r0[1], r1[1]}; OUT = *reinterpret_cast<bf16x8*>(&w); } while (0)
    PK4(p0, 0, pa0); PK4(p0, 8, pa1); PK4(p1, 0, pa2); PK4(p1, 8, pa3);
#undef PK4
}
template <int ND0, int KSW>
DEV void qkt(f32x16& p0, f32x16& p1, const char* Ks, const bf16x8* qr, int r32, int hi, int chunk0) {
    p0 = f32x16{}; p1 = f32x16{};
#pragma unroll
    for (int d0 = 0; d0 < ND0; ++d0) { const int ch = chunk0 + d0 * 2 + hi;
        const bf16x8 b0 = *reinterpret_cast<const bf16x8*>(Ks + kaddr<KSW>(r32, ch));
        const bf16x8 b1 = *reinterpret_cast<const bf16x8*>(Ks + kaddr<KSW>(32 + r32, ch));
        p0 = __builtin_amdgcn_mfma_f32_32x32x16_bf16(b0, qr[d0], p0, 0, 0, 0);
        p1 = __builtin_amdgcn_mfma_f32_32x32x16_bf16(b1, qr[d0], p1, 0, 0, 0); }
}
DEV int v_st(int k, int c) { const int kk = (k & ~0xC) | ((k & 4) << 1) | ((k & 8) >> 1); return ((kk >> 3) * 4 + (c >> 5)) * 512 + ((kk & 7) * 32 + (c & 31)) * 2; }
DEV int v_rd_base(int lane) { return ((lane & 3) << 3) | (((lane >> 2) & 3) << 6) | (((lane >> 4) & 1) << 5) | (((lane >> 5) & 1) << 8); }
constexpr int v_rd_off(int d0, int ks, int half) { return d0 * 512 + ks * 4096 + half * 2048; }
template <int OFF> DEV s16x4 tr_read(int vb) { s16x4 r; asm volatile("ds_read_b64_tr_b16 %0, %1 offset:%2" : "=&v"(r) : "v"(vb), "i"(OFF) : "memory"); return r; }
template <int D0> DEV void pv_one(f32x16& od, int vb, bf16x8 pa0, bf16x8 pa1, bf16x8 pa2, bf16x8 pa3) {
    const s16x4 l0 = tr_read<v_rd_off(D0, 0, 0)>(vb), h0 = tr_read<v_rd_off(D0, 0, 1)>(vb), l1 = tr_read<v_rd_off(D0, 1, 0)>(vb), h1 = tr_read<v_rd_off(D0, 1, 1)>(vb);
    const s16x4 l2 = tr_read<v_rd_off(D0, 2, 0)>(vb), h2 = tr_read<v_rd_off(D0, 2, 1)>(vb), l3 = tr_read<v_rd_off(D0, 3, 0)>(vb), h3 = tr_read<v_rd_off(D0, 3, 1)>(vb);
    asm volatile("s_waitcnt lgkmcnt(0)" ::: "memory"); SBAR();
#define PK(L, H) (bf16x8){L[0], L[1], L[2], L[3], H[0], H[1], H[2], H[3]}
    od = __builtin_amdgcn_mfma_f32_32x32x16_bf16(pa0, PK(l0, h0), od, 0, 0, 0);
    od = __builtin_amdgcn_mfma_f32_32x32x16_bf16(pa1, PK(l1, h1), od, 0, 0, 0);
    od = __builtin_amdgcn_mfma_f32_32x32x16_bf16(pa2, PK(l2, h2), od, 0, 0, 0);
    od = __builtin_amdgcn_mfma_f32_32x32x16_bf16(pa3, PK(l3, h3), od, 0, 0, 0);
#undef PK
}
DEV void pv_d4(f32x16* o, int vb, bf16x8 pa0, bf16x8 pa1, bf16x8 pa2, bf16x8 pa3) {
    pv_one<0>(o[0], vb, pa0, pa1, pa2, pa3); pv_one<1>(o[1], vb, pa0, pa1, pa2, pa3); pv_one<2>(o[2], vb, pa0, pa1, pa2, pa3); pv_one<3>(o[3], vb, pa0, pa1, pa2, pa3);
}

struct KV { const bf16_t *Kc, *Kl, *Vc, *Vl; long ldk, ldv; int nct; };

template <int ND0, int KSW, int KW16, int NKC, int SDEPTH>
DEV void attn_body(const int tid, const bf16x8* qr, const KV kv, int NT, float C, int chunk0, char* lds, f32x16 (&o)[4], float& l_reg, float* al_l) {
    constexpr int SHM_V = 16384, SHM_K = 64 * KW16 * 16;
    const int lane = tid & 63, r32 = lane & 31, hi = lane >> 5;
    char* V_lds = lds; char* K_lds = lds + 2 * SHM_V;
    float m_reg = -1e30f; l_reg = 0.f;
#pragma unroll
    for (int d = 0; d < 4; ++d) o[d] = f32x16{};
    const float thr_raw = THR * 1.4426950408889634f / C;
    const int vb0 = (int)(uintptr_t)V_lds + v_rd_base(lane);
    struct Slot { bf16x8 k[NKC]; bf16x8 v[2]; } sr_[SDEPTH];
#define SLOAD(i, T) do { const int _t = (T); const bf16_t* _kb = _t < kv.nct ? kv.Kc + (long)_t * 64 * kv.ldk : kv.Kl + (long)(_t - kv.nct) * 64 * kv.ldk;  \
        const bf16_t* _vb = _t < kv.nct ? kv.Vc + (long)_t * 64 * kv.ldv : kv.Vl + (long)(_t - kv.nct) * 64 * kv.ldv;                                       \
        _Pragma("unroll") for (int _q = 0; _q < 2; ++_q) { const int _id = tid + 512 * _q; sr_[i].v[_q] = *(const bf16x8*)(_vb + (long)(_id >> 4) * kv.ldv + (_id & 15) * 8); } \
        _Pragma("unroll") for (int _q = 0; _q < NKC; ++_q) { const int _id = tid + 512 * _q; sr_[i].k[_q] = *(const bf16x8*)(_kb + (long)(_id / KW16) * kv.ldk + (_id % KW16) * 8); } } while (0)
#define SWRITE(b, i) do {                                                                                                                                     \
        _Pragma("unroll") for (int _q = 0; _q < 2; ++_q) { const int _id = tid + 512 * _q; *(bf16x8*)(V_lds + (b) * SHM_V + v_st(_id >> 4, (_id & 15) * 8)) = sr_[i].v[_q]; } \
        _Pragma("unroll") for (int _q = 0; _q < NKC; ++_q) { const int _id = tid + 512 * _q; *(bf16x8*)(K_lds + (b) * SHM_K + kaddr<KSW>(_id / KW16, _id % KW16)) = sr_[i].k[_q]; } } while (0)
#define SWAIT() do { if constexpr (SDEPTH == 2) wait_vm<2 + NKC>(); else wait_vm<0>(); } while (0)
#define RESC(a) do { if (__any((a) < 1.f)) { if (hi == 0) al_l[r32] = (a); asm volatile("s_waitcnt lgkmcnt(0)" ::: "memory"); \
        _Pragma("unroll") for (int d = 0; d < 4; ++d) _Pragma("unroll") for (int r = 0; r < 16; ++r) o[d][r] *= al_l[crow(r, hi)]; } } while (0)
    f32x16 pA0, pA1, pB0, pB1; float mnA, mnB, alA, alB; bf16x8 pa0, pa1, pa2, pa3;
    constexpr int SE = 0, SO = SDEPTH - 1;
    SLOAD(SE, 0); wait_vm<0>(); SWRITE(0, SE); __syncthreads();
    qkt<ND0, KSW>(pA0, pA1, K_lds, qr, r32, hi, chunk0); partialSM(pA0, pA1, m_reg, mnA, alA, C, thr_raw);
    SLOAD(SO, 1); if constexpr (SDEPTH == 2) { if (2 < NT) SLOAD(SE, 2); }
    SWAIT(); SWRITE(1, SO); __syncthreads();
    for (int j = 1; j + 1 < NT; j += 2) {
        SBAR(); qkt<ND0, KSW>(pB0, pB1, K_lds + SHM_K, qr, r32, hi, chunk0);
        finishSM(pA0, pA1, alA, l_reg, pa0, pa1, pa2, pa3); SBAR();
        SLOAD(SO, j + SDEPTH); SBAR();
        pv_d4(o, vb0, pa0, pa1, pa2, pa3); partialSM(pB0, pB1, m_reg, mnB, alB, C, thr_raw);
        __syncthreads(); SWAIT(); SWRITE(0, SE);
        RESC(alB); __syncthreads();
        SBAR(); qkt<ND0, KSW>(pA0, pA1, K_lds, qr, r32, hi, chunk0);
        finishSM(pB0, pB1, alB, l_reg, pa0, pa1, pa2, pa3); SBAR();
        if (SDEPTH == 1 || j + 3 < NT) SLOAD(SE, j + 1 + SDEPTH); SBAR();
        pv_d4(o, vb0 + SHM_V, pa0, pa1, pa2, pa3); partialSM(pA0, pA1, m_reg, mnA, alA, C, thr_raw);
        __syncthreads(); SWAIT(); SWRITE(1, SO);
        RESC(alA); __syncthreads();
    }
    SBAR(); qkt<ND0, KSW>(pB0, pB1, K_lds + SHM_K, qr, r32, hi, chunk0);
    finishSM(pA0, pA1, alA, l_reg, pa0, pa1, pa2, pa3); SBAR();
    pv_d4(o, vb0, pa0, pa1, pa2, pa3); partialSM(pB0, pB1, m_reg, mnB, alB, C, thr_raw);
    __syncthreads(); RESC(alB);
    finishSM(pB0, pB1, alB, l_reg, pa0, pa1, pa2, pa3); SBAR();
    pv_d4(o, vb0 + SHM_V, pa0, pa1, pa2, pa3);
#undef SLOAD
#undef SWRITE
#undef SWAIT
#undef RESC
}
template <int ND0, int KSW, int KW16, int NKC>
DEV void attn_body1(const int tid, const bf16x8* qr, const KV kv, int NT, float C, int chunk0, char* lds, f32x16 (&o)[4], float& l_reg, float* al_l) {
    constexpr int SHM_V = 16384, SHM_K = 64 * KW16 * 16;
    const int lane = tid & 63, r32 = lane & 31, hi = lane >> 5;
    char* V_lds = lds; char* K_lds = lds + 2 * SHM_V;
    float m_reg = -1e30f; l_reg = 0.f;
#pragma unroll
    for (int d = 0; d < 4; ++d) o[d] = f32x16{};
    const float thr_raw = THR * 1.4426950408889634f / C;
    const int vb0 = (int)(uintptr_t)V_lds + v_rd_base(lane);
    bf16x8 sk[NKC], sv[2];
#define SLOAD1(T) do { const int _t = (T); const bf16_t* _kb = _t < kv.nct ? kv.Kc + (long)_t * 64 * kv.ldk : kv.Kl + (long)(_t - kv.nct) * 64 * kv.ldk;  \
        const bf16_t* _vb = _t < kv.nct ? kv.Vc + (long)_t * 64 * kv.ldv : kv.Vl + (long)(_t - kv.nct) * 64 * kv.ldv;                                    \
        _Pragma("unroll") for (int _q = 0; _q < 2; ++_q) { const int _id = tid + 512 * _q; sv[_q] = *(const bf16x8*)(_vb + (long)(_id >> 4) * kv.ldv + (_id & 15) * 8); } \
        _Pragma("unroll") for (int _q = 0; _q < NKC; ++_q) { const int _id = tid + 512 * _q; sk[_q] = *(const bf16x8*)(_kb + (long)(_id / KW16) * kv.ldk + (_id % KW16) * 8); } } while (0)
#define SWRITE1(b) do {                                                                                                                                    \
        _Pragma("unroll") for (int _q = 0; _q < 2; ++_q) { const int _id = tid + 512 * _q; *(bf16x8*)(V_lds + (b) * SHM_V + v_st(_id >> 4, (_id & 15) * 8)) = sv[_q]; } \
        _Pragma("unroll") for (int _q = 0; _q < NKC; ++_q) { const int _id = tid + 512 * _q; *(bf16x8*)(K_lds + (b) * SHM_K + kaddr<KSW>(_id / KW16, _id % KW16)) = sk[_q]; } } while (0)
    f32x16 p0, p1; float mn, al; bf16x8 pa0, pa1, pa2, pa3;
    SLOAD1(0); wait_vm<0>(); SWRITE1(0); __syncthreads();
    for (int j = 0; j < NT; ++j) {
        const int bsel = j & 1;
        if (j + 1 < NT) SLOAD1(j + 1);
        SBAR(); qkt<ND0, KSW>(p0, p1, K_lds + bsel * SHM_K, qr, r32, hi, chunk0);
        partialSM(p0, p1, m_reg, mn, al, C, thr_raw);
        if (__any(al < 1.f)) { if (hi == 0) al_l[r32] = al; asm volatile("s_waitcnt lgkmcnt(0)" ::: "memory");
#pragma unroll
            for (int d = 0; d < 4; ++d)
#pragma unroll
                for (int r = 0; r < 16; ++r) o[d][r] *= al_l[crow(r, hi)]; }
        finishSM(p0, p1, al, l_reg, pa0, pa1, pa2, pa3); SBAR();
        pv_d4(o, vb0 + bsel * SHM_V, pa0, pa1, pa2, pa3);
        if (j + 1 < NT) { wait_vm<0>(); SWRITE1(bsel ^ 1); }
        __syncthreads();
    }
#undef SLOAD1
#undef SWRITE1
}
}

DEV void da_unit(const P& p, int l, int b, int h, int qtok0  , bool ctxq, char* smem) {
    const int tid = lid();
    const int wid = tid >> 6, lane = tid & 63, r32 = lane & 31, hi = lane >> 5, sub = wid >> 2;
    const bf16_t* PR = wsb(p, OFF_PROJ);
    bf16x8 qr[4];
    { const bf16_t* q = PR + (size_t)(qtok0 + (wid & 3) * 32 + r32) * INP + C_DAQ + h * 128 + sub * 64 + hi * 8;
#pragma unroll
      for (int d0 = 0; d0 < 4; ++d0) qr[d0] = *(const bf16x8*)(q + d0 * 16); }
    at::KV kv; kv.ldk = INP; kv.ldv = INP; kv.nct = 4;
    kv.Kc = PR + (size_t)(TL + b * CTX) * INP + C_DAK + h * 128; kv.Vc = PR + (size_t)(TL + b * CTX) * INP + C_DAV + h * 128;
    kv.Kl = PR + (size_t)(b * SEQ) * INP + C_DAK + h * 128; kv.Vl = PR + (size_t)(b * SEQ) * INP + C_DAV + h * 128;
    float* wsl = (float*)(smem + 65536) + wid * 64; float* li_l = wsl; float* al_l = wsl + 32;
    f32x16 o[4]; float l_reg;
    at::attn_body<4, 0, 16, 2, 2>(tid, qr, kv, ctxq ? 4 : 36, 0.125f * 1.4426950408889634f, sub * 8, smem, o, l_reg, al_l);
    if (hi == 0) li_l[r32] = l_reg; asm volatile("s_waitcnt lgkmcnt(0)" ::: "memory");
#pragma unroll
    for (int r = 0; r < 16; ++r) { const float rl = __builtin_amdgcn_rcpf(li_l[at::crow(r, hi)]);
#pragma unroll
        for (int d = 0; d < 4; ++d) o[d][r] *= rl; }
    __syncthreads();
    float* xch = (float*)smem;
    if (wid >= 4) {
#pragma unroll
        for (int d = 0; d < 4; ++d)
#pragma unroll
            for (int r = 0; r < 16; ++r) xch[((wid - 4) * 64 + d * 16 + r) * 64 + lane] = o[d][r];
    }
    __syncthreads();
    if (wid < 4) {
        const float lam = wsf(p, OFF_MISC)[l * 2], om = 1.f - wsf(p, OFF_MISC)[l * 2 + 1];
        const float* sg = p.diff_sub_g + l * 128;
        float ss[16];
#pragma unroll
        for (int r = 0; r < 16; ++r) ss[r] = 0.f;
#pragma unroll
        for (int d = 0; d < 4; ++d)
#pragma unroll
            for (int r = 0; r < 16; ++r) { const float y = o[d][r] - lam * xch[(wid * 64 + d * 16 + r) * 64 + lane]; o[d][r] = y; ss[r] += y * y; }
#pragma unroll
        for (int r = 0; r < 16; ++r) {
            ss[r] += xshf<1>(ss[r]); ss[r] += xshf<2>(ss[r]); ss[r] += xshf<4>(ss[r]); ss[r] += xshf<8>(ss[r]); ss[r] += xshf<16>(ss[r]);
            ss[r] = rsqrtf(ss[r] * (1.f / 128.f) + EPS) * om;
        }
        bf16_t* Y = wsb(p, OFF_Y) + (size_t)(qtok0 + wid * 32) * DM + 0 + h * 128;
#pragma unroll
        for (int d = 0; d < 4; ++d) { const float g = sg[d * 32 + r32];
#pragma unroll
            for (int r = 0; r < 16; ++r) Y[(size_t)at::crow(r, hi) * DM + d * 32 + r32] = f2bf(o[d][r] * ss[r] * g); }
    }
    __syncthreads();
}
DEV void mla_unit(const P& p, int b, int h, int qtok0, bool ctxq, char* smem) {
    const int tid = lid();
    const int wid = tid >> 6, lane = tid & 63, r32 = lane & 31, hi = lane >> 5;
    bf16x8 qr[12];
    { const bf16_t* q = wsb(p, OFF_QM) + (size_t)(qtok0 + wid * 32 + r32) * 768 + h * 192 + hi * 8;
#pragma unroll
      for (int d0 = 0; d0 < 12; ++d0) qr[d0] = *(const bf16x8*)(q + d0 * 16); }
    const bf16_t* KM = wsb(p, OFF_KM); const bf16_t* KVM = wsb(p, OFF_KVM);
    at::KV kv; kv.ldk = 768; kv.ldv = 1024; kv.nct = 4;
    kv.Kc = KM + (size_t)(TL + b * CTX) * 768 + h * 192; kv.Vc = KVM + (size_t)(TL + b * CTX) * 1024 + h * 256 + 128;
    kv.Kl = KM + (size_t)(b * SEQ) * 768 + h * 192; kv.Vl = KVM + (size_t)(b * SEQ) * 1024 + h * 256 + 128;
    float* wsl = (float*)(smem + 32768 + 49152) + wid * 64; float* li_l = wsl; float* al_l = wsl + 32;
    f32x16 o[4]; float l_reg;
    at::attn_body1<12, 1, 24, 3>(tid, qr, kv, ctxq ? 4 : 36, 0.07216878364870322f * 1.4426950408889634f, 0, smem, o, l_reg, al_l);
    if (hi == 0) li_l[r32] = l_reg; asm volatile("s_waitcnt lgkmcnt(0)" ::: "memory");
    bf16_t* Y = wsb(p, OFF_Y) + (size_t)(qtok0 + wid * 32) * DM + 1536 + h * 128;
#pragma unroll
    for (int r = 0; r < 16; ++r) { const float rl = __builtin_amdgcn_rcpf(li_l[at::crow(r, hi)]);
#pragma unroll
        for (int d = 0; d < 4; ++d) Y[(size_t)at::crow(r, hi) * DM + d * 32 + r32] = f2bf(o[d][r] * rl); }
    __syncthreads();
}

DEV void pack_p(const f32x16& p0, const f32x16& p1, bf16x8& pa0, bf16x8& pa1, bf16x8& pa2, bf16x8& pa3) {
#define PK4(Pq, BASE, OUT) do { unsigned a0 = cvtpk(Pq[BASE + 0], Pq[BASE + 1]), a1 = cvtpk(Pq[BASE + 2], Pq[BASE + 3]);   \
    unsigned b0 = cvtpk(Pq[BASE + 4], Pq[BASE + 5]), b1 = cvtpk(Pq[BASE + 6], Pq[BASE + 7]);                              \
    auto r0 = __builtin_amdgcn_permlane32_swap(a0, b0, false, false); auto r1 = __builtin_amdgcn_permlane32_swap(a1, b1, false, false); \
    u32x4 w = {r0[0], r1[0], r0[1], r1[1]}; OUT = *reinterpret_cast<bf16x8*>(&w); } while (0)
    PK4(p0, 0, pa0); PK4(p0, 8, pa1); PK4(p1, 0, pa2); PK4(p1, 8, pa3);
#undef PK4
}
DEV void na_unit(const P& p, int l, int b, int r, int hg, bool ctxq, char* smem) {
    const int tid = lid();
    const int wid = tid >> 6, lane = tid & 63, r32 = lane & 31, hi = lane >> 5, hh = wid >> 1, qh = wid & 1;
    const bf16_t* PR = wsb(p, OFF_PROJ);
    const int qtok = ctxq ? TL + b * CTX + r * 64 : b * SEQ + r * 64;
    bf16x8 qr[4];
    { const bf16_t* q = PR + (size_t)(qtok + qh * 32 + r32) * INP + C_NAQ + (hg * 4 + hh) * 64 + hi * 8;
#pragma unroll
      for (int d0 = 0; d0 < 4; ++d0) qr[d0] = *(const bf16x8*)(q + d0 * 16); }
    char* Ks = smem; char* Vs = smem + 32768; float* bias = (float*)(smem + 65536); float* al_l = (float*)(smem + 65536 + 4096) + wid * 64; float* li_l = al_l + 32;
    const int rs = min(max(r - 4, 0), 24), nloc = ctxq ? 0 : 8, NT = nloc + 4;
    __syncthreads();
    if (!ctxq) for (int e = tid; e < 1024; e += 512) { const int h_ = e >> 8, i = (e >> 5) & 7, dc = e & 31, dr = rs + i - r + 7;
        bias[e] = dc < 31 ? p.na_rpb[(((size_t)l * 8 + hg * 4 + h_) * 15 + dr) * 31 + dc] * 1.4426950408889634f : 0.f; }
    constexpr float C = 0.125f * 1.4426950408889634f;
    float m_reg = -1e30f, l_reg = 0.f; f32x16 o[2] = {};
    const int vb = (int)(uintptr_t)Vs + (hh >> 1) * 16384 + (hh & 1) * 1024 + at::v_rd_base(lane);
    bf16x8 sk[4], sv[4];
#define NA_LOAD(T) do { const int _t = (T); const int _kt0 = _t < nloc ? b * SEQ + (rs + _t) * 64 : TL + b * CTX + (_t - nloc) * 64;                         \
        _Pragma("unroll") for (int q = 0; q < 4; ++q) { const int id = tid + 512 * q, row = id >> 5, ch = id & 31;                                                 \
            sk[q] = *(const bf16x8*)(PR + (size_t)(_kt0 + row) * INP + C_NAK + hg * 256 + ch * 8);                                                                \
            sv[q] = *(const bf16x8*)(PR + (size_t)(_kt0 + row) * INP + C_NAV + hg * 256 + ch * 8); } } while (0)
    NA_LOAD(0);
    for (int t = 0; t < NT; ++t) {
        __syncthreads();
#pragma unroll
        for (int q = 0; q < 4; ++q) { const int id = tid + 512 * q, row = id >> 5, ch = id & 31;
            *(bf16x8*)(Ks + at::kaddr<2>(row, ch)) = sk[q];
            *(bf16x8*)(Vs + (ch >> 4) * 16384 + at::v_st(row, (ch & 15) * 8)) = sv[q]; }
        __syncthreads();
        if (t + 1 < NT) NA_LOAD(t + 1);
        f32x16 p0, p1;
        at::qkt<4, 2>(p0, p1, Ks, qr, r32, hi, hh * 8);
        if (t < nloc) {
            const int c = qh * 32 + r32, cs = min(max(c - 8, 0), 48); const float* bt = bias + (hh * 8 + t) * 32;
#pragma unroll
            for (int rr = 0; rr < 16; ++rr) {
                const int k0 = at::crow(rr, hi), k1 = 32 + k0, d0 = k0 - c + 15, d1 = k1 - c + 15;
                const float b0 = bt[min(max(d0, 0), 31)], b1 = bt[min(max(d1, 0), 31)];
                p0[rr] = (k0 >= cs && k0 < cs + 16) ? fmaf(p0[rr], C, b0) : -1e30f;
                p1[rr] = (k1 >= cs && k1 < cs + 16) ? fmaf(p1[rr], C, b1) : -1e30f;
            }
        } else {
#pragma unroll
            for (int rr = 0; rr < 16; ++rr) { p0[rr] *= C; p1[rr] *= C; }
        }
        float pmax = p0[0];
#pragma unroll
        for (int rr = 1; rr < 16; ++rr) pmax = fmaxf(pmax, p0[rr]);
#pragma unroll
        for (int rr = 0; rr < 16; ++rr) pmax = fmaxf(pmax, p1[rr]);
        pmax = fmaxf(pmax, xshf<32>(pmax));
        const float mn = fmaxf(m_reg, pmax), al = __builtin_amdgcn_exp2f(m_reg - mn); m_reg = mn;
        float ps = 0.f;
#pragma unroll
        for (int rr = 0; rr < 16; ++rr) { p0[rr] = __builtin_amdgcn_exp2f(p0[rr] - mn); p1[rr] = __builtin_amdgcn_exp2f(p1[rr] - mn); ps += p0[rr] + p1[rr]; }
        ps += xshf<32>(ps);
        l_reg = l_reg * al + ps;
        if (hi == 0) al_l[r32] = al; asm volatile("s_waitcnt lgkmcnt(0)" ::: "memory");
#pragma unroll
        for (int d = 0; d < 2; ++d)
#pragma unroll
            for (int rr = 0; rr < 16; ++rr) o[d][rr] *= al_l[at::crow(rr, hi)];
        bf16x8 pa0, pa1, pa2, pa3; pack_p(p0, p1, pa0, pa1, pa2, pa3);
        at::pv_one<0>(o[0], vb, pa0, pa1, pa2, pa3); at::pv_one<1>(o[1], vb, pa0, pa1, pa2, pa3);
    }
#undef NA_LOAD
    if (hi == 0) li_l[r32] = l_reg; asm volatile("s_waitcnt lgkmcnt(0)" ::: "memory");
    bf16_t* Y = wsb(p, OFF_Y) + (size_t)(qtok + qh * 32) * DM + 1024 + (hg * 4 + hh) * 64;
#pragma unroll
    for (int rr = 0; rr < 16; ++rr) { const float rl = __builtin_amdgcn_rcpf(li_l[at::crow(rr, hi)]);
#pragma unroll
        for (int d = 0; d < 2; ++d) Y[(size_t)at::crow(rr, hi) * DM + d * 32 + r32] = f2bf(o[d][rr] * rl); }
    __syncthreads();
}

DEV int rt_tok0(int b, int n) { return n < 2 ? TL + b * CTX + n * 128 : b * SEQ + (n - 2) * 128; }
DEV int rt_sidx(int b, int h, int dir, int n) { const int sp = dir == 0 ? n : (n < 2 ? 1 - n : 19 - n); return (((b * 4 + h) * 2 + dir) * 18 + sp); }
DEV void rts_unit(const P& p, int l, int b, int h, int n, char* smem) {
    const int tid = lid();
    const int wid = tid >> 6, lane = tid & 63, r32 = lane & 31, hi = lane >> 5;
    const bf16_t* PR = wsb(p, OFF_PROJ); const int tok0 = rt_tok0(b, n);
    const float l2gf = wsf(p, OFF_MISC)[8 + (l * 2 + 0) * 4 + h], l2gb = wsf(p, OFF_MISC)[8 + (l * 2 + 1) * 4 + h];
    bf16_t* KtF = (bf16_t*)smem; bf16_t* KtB = KtF + 128 * 136; bf16_t* Vt = KtB + 128 * 136;
    __syncthreads();
#pragma unroll
    for (int q = 0; q < 4; ++q) { const int id = tid + 512 * q, j = id & 127, ch = id >> 7;
        const u32x4 kw = *(const u32x4*)(PR + (size_t)(tok0 + j) * INP + C_RTK + h * 128 + ch * 8);
        const u32x4 vw = *(const u32x4*)(PR + (size_t)(tok0 + j) * INP + C_RTV + h * 128 + ch * 8);
        const float zf = __builtin_amdgcn_exp2f(l2gf * (float)(127 - j)), zb = __builtin_amdgcn_exp2f(l2gb * (float)j);
        const unsigned kk[4] = {kw.x, kw.y, kw.z, kw.w}, vv[4] = {vw.x, vw.y, vw.z, vw.w};
#pragma unroll
        for (int e = 0; e < 4; ++e) { const float k0 = bflo(kk[e]), k1 = bfhi(kk[e]);
            KtF[(ch * 8 + e * 2) * 136 + j] = f2bf(k0 * zf); KtF[(ch * 8 + e * 2 + 1) * 136 + j] = f2bf(k1 * zf);
            KtB[(ch * 8 + e * 2) * 136 + j] = f2bf(k0 * zb); KtB[(ch * 8 + e * 2 + 1) * 136 + j] = f2bf(k1 * zb);
            Vt[(ch * 8 + e * 2) * 136 + j] = (bf16_t)(vv[e] & 0xffffu); Vt[(ch * 8 + e * 2 + 1) * 136 + j] = (bf16_t)(vv[e] >> 16); }
    }
    __syncthreads();
    const int eb = wid & 3, db0 = (wid >> 2) * 2;
    f32x16 aF[2] = {}, aB[2] = {};
#pragma unroll
    for (int ks = 0; ks < 8; ++ks) {
        const bf16x8 a = *(const bf16x8*)(Vt + (eb * 32 + r32) * 136 + ks * 16 + hi * 8);
#pragma unroll
        for (int dd = 0; dd < 2; ++dd) {
            const bf16x8 bF = *(const bf16x8*)(KtF + ((db0 + dd) * 32 + r32) * 136 + ks * 16 + hi * 8);
            const bf16x8 bB = *(const bf16x8*)(KtB + ((db0 + dd) * 32 + r32) * 136 + ks * 16 + hi * 8);
            aF[dd] = __builtin_amdgcn_mfma_f32_32x32x16_bf16(a, bF, aF[dd], 0, 0, 0);
            aB[dd] = __builtin_amdgcn_mfma_f32_32x32x16_bf16(a, bB, aB[dd], 0, 0, 0);
        }
    }
    float* SF = wsf(p, OFF_ST) + (size_t)rt_sidx(b, h, 0, n) * 16384; float* SB = wsf(p, OFF_ST) + (size_t)rt_sidx(b, h, 1, n) * 16384;
#pragma unroll
    for (int dd = 0; dd < 2; ++dd)
#pragma unroll
        for (int rr = 0; rr < 16; ++rr) { const int e = eb * 32 + at::crow(rr, hi), d = (db0 + dd) * 32 + r32; SF[e * 128 + d] = aF[dd][rr]; SB[e * 128 + d] = aB[dd][rr]; }
    __syncthreads();
}
DEV void phase_rtp(const P& p, int l, int bid, int nb) {
    const int tix = lid();
    for (int g = bid * 512 + tix; g < 64 * 4096; g += nb * 512) {
        const int seq = g >> 12, el = (g & 4095) * 4; const int dir = seq & 1, h = (seq >> 1) & 3;
        const float gC = __builtin_amdgcn_exp2f(wsf(p, OFF_MISC)[8 + (l * 2 + dir) * 4 + h] * 128.f);
        const float* S = wsf(p, OFF_ST) + (size_t)seq * 18 * 16384 + el; bf16_t* R = wsb(p, OFF_RT) + (size_t)seq * 18 * 16384 + el;
        float z0 = 0.f; asm volatile("" : "+v"(z0));
        f32x4 acc = {z0, z0, z0, z0};
        for (int sp = 0; sp < 18; ++sp) {
            u32x2 w; w.x = cvtpk(acc[0], acc[1]); w.y = cvtpk(acc[2], acc[3]); *(u32x2*)(R + (size_t)sp * 16384) = w;
            const f32x4 s = *(const f32x4*)(S + (size_t)sp * 16384); acc = acc * gC + s;
        }
    }
}
DEV void rto_unit(const P& p, int l, int b, int h, int n, char* smem) {
    const int tid = lid();
    const int wid = tid >> 6, lane = tid & 63, r32 = lane & 31, hi = lane >> 5;
    const bf16_t* PR = wsb(p, OFF_PROJ); const int tok0 = rt_tok0(b, n);
    const float l2gf = wsf(p, OFF_MISC)[8 + (l * 2 + 0) * 4 + h], l2gb = wsf(p, OFF_MISC)[8 + (l * 2 + 1) * 4 + h];
    bf16_t* Qs = (bf16_t*)smem; bf16_t* Ks = Qs + 128 * 136; bf16_t* Vt = Ks + 128 * 136; float* Os = (float*)smem;
    __syncthreads();
#pragma unroll
    for (int q = 0; q < 4; ++q) {
        { const int id = tid + 512 * q, j = id >> 4, ch = id & 15;
          *(u32x4*)(Qs + j * 136 + ch * 8) = *(const u32x4*)(PR + (size_t)(tok0 + j) * INP + C_RTQ + h * 128 + ch * 8);
          *(u32x4*)(Ks + j * 136 + ch * 8) = *(const u32x4*)(PR + (size_t)(tok0 + j) * INP + C_RTK + h * 128 + ch * 8); }
        { const int id = tid + 512 * q, j = id & 127, ch = id >> 7;
          const u32x4 vw = *(const u32x4*)(PR + (size_t)(tok0 + j) * INP + C_RTV + h * 128 + ch * 8);
          const unsigned vv[4] = {vw.x, vw.y, vw.z, vw.w};
#pragma unroll
          for (int e = 0; e < 4; ++e) { Vt[(ch * 8 + e * 2) * 136 + j] = (bf16_t)(vv[e] & 0xffffu); Vt[(ch * 8 + e * 2 + 1) * 136 + j] = (bf16_t)(vv[e] >> 16); } }
    }
    __syncthreads();
    const int nb_ = wid & 3, ebh = wid >> 2, nl = nb_ * 32 + r32;
    bf16x8 bq[8];
#pragma unroll
    for (int ks = 0; ks < 8; ++ks) bq[ks] = *(const bf16x8*)(Qs + (nb_ * 32 + r32) * 136 + ks * 16 + hi * 8);
    bf16x8 pb[8];
#pragma unroll
    for (int mb = 0; mb < 4; ++mb) {
        f32x16 s = {};
#pragma unroll
        for (int ks = 0; ks < 8; ++ks) { const bf16x8 a = *(const bf16x8*)(Ks + (mb * 32 + r32) * 136 + ks * 16 + hi * 8); s = __builtin_amdgcn_mfma_f32_32x32x16_bf16(a, bq[ks], s, 0, 0, 0); }
#pragma unroll
        for (int rr = 0; rr < 16; ++rr) { const int dlt = nl - (mb * 32 + at::crow(rr, hi));
            const float f = dlt > 0 ? __builtin_amdgcn_exp2f(l2gf * (float)dlt) : (dlt < 0 ? __builtin_amdgcn_exp2f(l2gb * (float)(-dlt)) : 2.f); s[rr] *= f; }
        u32x4 w0 = {cvtpk(s[0], s[1]), cvtpk(s[2], s[3]), cvtpk(s[4], s[5]), cvtpk(s[6], s[7])};
        u32x4 w1 = {cvtpk(s[8], s[9]), cvtpk(s[10], s[11]), cvtpk(s[12], s[13]), cvtpk(s[14], s[15])};
        pb[mb * 2] = *reinterpret_cast<bf16x8*>(&w0); pb[mb * 2 + 1] = *reinterpret_cast<bf16x8*>(&w1);
    }
    const bf16_t* RF = wsb(p, OFF_RT) + (size_t)rt_sidx(b, h, 0, n) * 16384; const bf16_t* RB = wsb(p, OFF_RT) + (size_t)rt_sidx(b, h, 1, n) * 16384;
    const float xif = __builtin_amdgcn_exp2f(l2gf * (float)(nl + 1)), xib = __builtin_amdgcn_exp2f(l2gb * (float)(128 - nl));
    f32x16 out[2];
#pragma unroll
    for (int dd = 0; dd < 2; ++dd) {
        const int e0 = (ebh * 2 + dd) * 32;
        f32x16 in_ = {}, cf = {}, cb = {};
#pragma unroll
        for (int kk = 0; kk < 8; ++kk) {
            const s16x4 lo = *(const s16x4*)(Vt + (e0 + r32) * 136 + kk * 16 + 4 * hi), hi4 = *(const s16x4*)(Vt + (e0 + r32) * 136 + kk * 16 + 8 + 4 * hi);
            const bf16x8 a = {lo[0], lo[1], lo[2], lo[3], hi4[0], hi4[1], hi4[2], hi4[3]};
            in_ = __builtin_amdgcn_mfma_f32_32x32x16_bf16(a, pb[kk], in_, 0, 0, 0);
        }
#pragma unroll
        for (int ks = 0; ks < 8; ++ks) {
            const bf16x8 af = *(const bf16x8*)(RF + (e0 + r32) * 128 + ks * 16 + hi * 8), ab = *(const bf16x8*)(RB + (e0 + r32) * 128 + ks * 16 + hi * 8);
            cf = __builtin_amdgcn_mfma_f32_32x32x16_bf16(af, bq[ks], cf, 0, 0, 0);
            cb = __builtin_amdgcn_mfma_f32_32x32x16_bf16(ab, bq[ks], cb, 0, 0, 0);
        }
#pragma unroll
        for (int rr = 0; rr < 16; ++rr) out[dd][rr] = in_[rr] + xif * cf[rr] + xib * cb[rr];
    }
    __syncthreads();
#pragma unroll
    for (int dd = 0; dd < 2; ++dd)
#pragma unroll
        for (int rr = 0; rr < 16; ++rr) Os[nl * 129 + (ebh * 2 + dd) * 32 + at::crow(rr, hi)] = out[dd][rr];
    __syncthreads();
    {
        const int nr = tid >> 2, part = tid & 3;
        float v[32]; float ss = 0.f;
#pragma unroll
        for (int i = 0; i < 32; ++i) { v[i] = Os[nr * 129 + part * 32 + i]; ss += v[i] * v[i]; }
        ss += xshf<1>(ss); ss += xshf<2>(ss);
        const float rs = rsqrtf(ss * (1.f / 128.f) + EPS);
        const float* ng = p.ret_norm_g + l * 128 + part * 32;
        const bf16_t* gp = PR + (size_t)(tok0 + nr) * INP + C_RTG + h * 128 + part * 32;
        bf16_t* yp = wsb(p, OFF_Y) + (size_t)(tok0 + nr) * DM + 512 + h * 128 + part * 32;
#pragma unroll
        for (int c = 0; c < 4; ++c) {
            const u32x4 gw = *(const u32x4*)(gp + c * 8); const unsigned gg[4] = {gw.x, gw.y, gw.z, gw.w};
            float y[8];
#pragma unroll
            for (int e = 0; e < 4; ++e) { y[e * 2] = v[c * 8 + e * 2] * rs * ng[c * 8 + e * 2] * siluf_(bflo(gg[e])); y[e * 2 + 1] = v[c * 8 + e * 2 + 1] * rs * ng[c * 8 + e * 2 + 1] * siluf_(bfhi(gg[e])); }
            u32x4 w = {cvtpk(y[0], y[1]), cvtpk(y[2], y[3]), cvtpk(y[4], y[5]), cvtpk(y[6], y[7])};
            *(u32x4*)(yp + c * 8) = w;
        }
    }
    __syncthreads();
}

DEV void peer_scores_phase(const P& p, int l, int nunits, int bid, int nb) {
    const int tid = lid();
    const int wid = tid >> 6, lane = tid & 63, r32 = lane & 31, hi = lane >> 5;
    int u = bid; if (u >= nunits) return;
    bf16x8 bq[8], bqn[8];
    { const bf16_t* q = wsb(p, OFF_QP) + (size_t)((u >> 4) * 256 + wid * 32 + r32) * DM + (u & 15) * 128 + hi * 8;
#pragma unroll
      for (int ks = 0; ks < 8; ++ks) bq[ks] = *(const bf16x8*)(q + ks * 16); }
#pragma unroll 1
    for (; u < nunits; u += nb) {
        const int tile = u >> 4, hs = u & 15, tok = tile * 256 + wid * 32 + r32, un = u + nb;
        if (un < nunits) { const bf16_t* q = wsb(p, OFF_QP) + (size_t)((un >> 4) * 256 + wid * 32 + r32) * DM + (un & 15) * 128 + hi * 8;
#pragma unroll
            for (int ks = 0; ks < 8; ++ks) bqn[ks] = *(const bf16x8*)(q + ks * 16); }
        const bf16_t* sk = wl(p, l, W_SK) + (size_t)hs * 16384 + hi * 8;
        float* SC = wsf(p, OFF_SC) + (size_t)hs * 128 * TA + tok;
#pragma unroll
        for (int kb = 0; kb < 4; ++kb) {
            f32x16 acc = {};
#pragma unroll
            for (int ks = 0; ks < 8; ++ks) { const bf16x8 a = *(const bf16x8*)(sk + (size_t)(kb * 32 + r32) * 128 + ks * 16); acc = __builtin_amdgcn_mfma_f32_32x32x16_bf16(a, bq[ks], acc, 0, 0, 0); }
#pragma unroll
            for (int rr = 0; rr < 16; ++rr) SC[(size_t)(kb * 32 + at::crow(rr, hi)) * TA] = acc[rr];
        }
#pragma unroll
        for (int ks = 0; ks < 8; ++ks) bq[ks] = bqn[ks];
    }
}
DEV unsigned mono(float v) { const unsigned u = __float_as_uint(v); return (u & 0x80000000u) ? ~u : (u | 0x80000000u); }
DEV float unmono(unsigned m) { return __uint_as_float((m & 0x80000000u) ? (m ^ 0x80000000u) : ~m); }
#define INS16(L, key) do { unsigned _k = (key); _Pragma("unroll") for (int _q = 0; _q < 16; ++_q) { const unsigned _h = max(L[_q], _k); _k = min(L[_q], _k); L[_q] = _h; } } while (0)
#define CE_DESC(a, b) do { const unsigned _h = max(a, b); b = min(a, b); a = _h; } while (0)
DEV void bitonic_sort_desc16(unsigned (&a)[16]) {
#pragma unroll
    for (int k = 2; k <= 16; k <<= 1)
#pragma unroll
        for (int j = k >> 1; j > 0; j >>= 1)
#pragma unroll
            for (int i = 0; i < 16; ++i) { const int l_ = i ^ j; if (l_ > i) { if ((i & k) == 0) CE_DESC(a[i], a[l_]); else CE_DESC(a[l_], a[i]); } }
}
DEV void bitonic_merge_desc16(unsigned (&a)[16]) {
#pragma unroll
    for (int j = 8; j > 0; j >>= 1)
#pragma unroll
        for (int i = 0; i < 16; ++i) { const int l_ = i ^ j; if (l_ > i) CE_DESC(a[i], a[l_]); }
}
DEV void top16_fold_sorted(unsigned (&L)[16], const unsigned (&N)[16]) {
#pragma unroll
    for (int q = 0; q < 16; ++q) L[q] = max(L[q], N[15 - q]);
    bitonic_merge_desc16(L);
}
DEV void peer_topk_task(const P& p, int h, int tok0, char* smem) {
    const int tid = lid();
    const int wid = tid >> 6, lane = tid & 63, tok = tok0 + lane;
    unsigned* lst = (unsigned*)smem + wid * 2048;
    const float* s0 = wsf(p, OFF_SC) + ((size_t)(h * (TA / 64) + (tok0 >> 6)) * 256) * 64 + lane; const float* s1 = s0 + 128 * 64;
    unsigned La[16], Lb[16];
#pragma unroll 1
    for (int i = 0; i < 128; i += 16) {
        float va[16], vb[16];
#pragma unroll
        for (int q = 0; q < 16; ++q) { va[q] = s0[(i + q) * 64]; vb[q] = s1[(i + q) * 64]; }
        unsigned Na[16], Nb[16];
#pragma unroll
        for (int q = 0; q < 16; ++q) { Na[q] = (mono(va[q]) & ~127u) | (unsigned)(127 - (i + q)); Nb[q] = (mono(vb[q]) & ~127u) | (unsigned)(127 - (i + q)); }
        bitonic_sort_desc16(Na); bitonic_sort_desc16(Nb);
        if (i == 0) {
#pragma unroll
            for (int q = 0; q < 16; ++q) { La[q] = Na[q]; Lb[q] = Nb[q]; }
        } else { top16_fold_sorted(La, Na); top16_fold_sorted(Lb, Nb); }
    }
#pragma unroll
    for (int q = 0; q < 16; ++q) { lst[q * 64 + lane] = La[q]; lst[(16 + q) * 64 + lane] = Lb[q]; }
    float fa[16], fb[16];
#pragma unroll
    for (int q = 0; q < 16; ++q) { fa[q] = unmono(La[q] & ~127u); fb[q] = unmono(Lb[q] & ~127u); }
#define CANDK(i, j) ((mono(fa[i] + fb[j]) & ~255u) | (unsigned)(255 - ((i) * 16 + (j))))
    unsigned L2[16];
#pragma unroll
    for (int q = 0; q < 16; ++q) L2[q] = CANDK(0, q);
    {   unsigned N[16];
#pragma unroll
        for (int q = 0; q < 15; ++q) N[q] = CANDK(q + 1, 0);
        N[15] = 0u;
        top16_fold_sorted(L2, N);
    }
    {
        constexpr int RI[19] = {1, 1, 1, 1, 1, 1, 1, 2, 2, 2, 2, 3, 3, 3, 4, 4, 5, 6, 7}, RJ[19] = {1, 2, 3, 4, 5, 6, 7, 1, 2, 3, 4, 1, 2, 3, 1, 2, 1, 1, 1};
        unsigned N[16];
#pragma unroll
        for (int q = 0; q < 16; ++q) N[q] = CANDK(RI[q], RJ[q]);
        bitonic_sort_desc16(N);
        top16_fold_sorted(L2, N);
#pragma unroll
        for (int q = 16; q < 19; ++q) INS16(L2, CANDK(RI[q], RJ[q]));
    }
#undef CANDK
    asm volatile("s_waitcnt lgkmcnt(0)" ::: "memory");
    float ev[16]; int ex[16]; float sum = 0.f; const float mx = unmono(L2[0] & ~255u);
#pragma unroll
    for (int k = 0; k < 16; ++k) {
        const int pos = 255 - (int)(L2[k] & 255u), i = pos >> 4, j = pos & 15;
        const unsigned ka = lst[i * 64 + lane], kb = lst[(16 + j) * 64 + lane];
        ex[k] = (127 - (int)(ka & 127u)) * 128 + (127 - (int)(kb & 127u));
        ev[k] = __expf(unmono(L2[k] & ~255u) - mx); sum += ev[k];
    }
    const float inv = 1.f / sum;
    unsigned short* pi = (unsigned short*)(p.ws + OFF_PIDX) + (size_t)tok * 128; float* pw = wsf(p, OFF_PW) + (size_t)tok * 128;
#pragma unroll
    for (int k = 0; k < 8; ++k) { const int slot = k * 16 + h * 2;
        *(unsigned*)(pi + slot) = (unsigned)ex[k] | ((unsigned)ex[k + 8] << 16); *(f32x2*)(pw + slot) = (f32x2){ev[k] * inv, ev[k + 8] * inv}; }
}
DEV float dot16(const u32x4 w, const float* h) {
    float s = 0.f;
#pragma unroll
    for (int k = 0; k < 4; ++k) { const f32x2 a = __builtin_amdgcn_cvt_pk_f32_fp8((int)w[k], false), b = __builtin_amdgcn_cvt_pk_f32_fp8((int)w[k], true);
        s += a[0] * h[4 * k] + a[1] * h[4 * k + 1] + b[0] * h[4 * k + 2] + b[1] * h[4 * k + 3]; }
    return s;
}
DEV void peer_gather_token(const P& p, int l, int tok, float* xl, float* xc, int lane, bool commit = true) {
    const unsigned char* U = (const unsigned char*)wl(p, l, W_U); const unsigned char* V = (const unsigned char*)wl(p, l, W_V);
    const float* US = (const float*)wl(p, l, W_US); const float* VS = (const float*)wl(p, l, W_VS);
    float hq[32];
    { const bf16_t* hrow = wsb(p, OFF_H) + (size_t)tok * DM + lane * 16;
#pragma unroll
      for (int c = 0; c < 2; ++c) { const u32x4 a = *(const u32x4*)(hrow + c * 1024), b = *(const u32x4*)(hrow + c * 1024 + 8);
          hq[c * 16 + 0] = bflo(a.x); hq[c * 16 + 1] = bfhi(a.x); hq[c * 16 + 2] = bflo(a.y); hq[c * 16 + 3] = bfhi(a.y); hq[c * 16 + 4] = bflo(a.z); hq[c * 16 + 5] = bfhi(a.z); hq[c * 16 + 6] = bflo(a.w); hq[c * 16 + 7] = bfhi(a.w);
          hq[c * 16 + 8] = bflo(b.x); hq[c * 16 + 9] = bfhi(b.x); hq[c * 16 + 10] = bflo(b.y); hq[c * 16 + 11] = bfhi(b.y); hq[c * 16 + 12] = bflo(b.z); hq[c * 16 + 13] = bfhi(b.z); hq[c * 16 + 14] = bflo(b.w); hq[c * 16 + 15] = bfhi(b.w); } }
    const int* pi = (const int*)(p.ws + OFF_PIDX) + (size_t)tok * 128; const float* pw = wsf(p, OFF_PW) + (size_t)tok * 128;
    const int i0 = pi[lane], i1 = pi[64 + lane];
    const float us0 = US[i0], us1 = US[i1];
    const float gv0 = pw[lane] * VS[i0], gv1 = pw[64 + lane] * VS[i1];
    float w0 = 0.f, w1 = 0.f;
    for (int eb = 0; eb < 16; ++eb) {
        u32x4 ur[8][2];
#pragma unroll
        for (int q = 0; q < 8; ++q) { const int e = eb * 8 + q; const int idx = __builtin_amdgcn_readlane(e < 64 ? i0 : i1, e & 63);
            const unsigned char* ur_ = U + (size_t)idx * DM;
#pragma unroll
            for (int c = 0; c < 2; ++c) ur[q][c] = *(const u32x4*)(ur_ + (unsigned)(lane * 16 + c * 1024)); }
#pragma unroll
        for (int q = 0; q < 8; ++q) { const int e = eb * 8 + q;
            float d = dot16(ur[q][0], hq) + dot16(ur[q][1], hq + 16);
            d = wave_sum(d) * (e < 64 ? us0 : us1);
            const float a = 0.5f * d * (1.f + erff(d * 0.70710678118654752f));
            if ((e & 63) == lane) { if (e < 64) w0 = a * gv0; else w1 = a * gv1; }
            __builtin_amdgcn_sched_barrier(0); }
    }
    float acc[32];
#pragma unroll
    for (int i = 0; i < 32; ++i) acc[i] = 0.f;
    for (int eb = 0; eb < 16; ++eb) {
        u32x4 vr[8][2]; float wv[8];
#pragma unroll
        for (int q = 0; q < 8; ++q) { const int e = eb * 8 + q; const int idx = __builtin_amdgcn_readlane(e < 64 ? i0 : i1, e & 63);
            wv[q] = __uint_as_float((unsigned)__builtin_amdgcn_readlane((int)__float_as_uint(e < 64 ? w0 : w1), e & 63));
            const unsigned char* vr_ = V + (size_t)idx * DM;
#pragma unroll
            for (int c = 0; c < 2; ++c) vr[q][c] = *(const u32x4*)(vr_ + (unsigned)(lane * 16 + c * 1024)); }
#pragma unroll
        for (int q = 0; q < 8; ++q) {
#pragma unroll
            for (int c = 0; c < 2; ++c)
#pragma unroll
                for (int k = 0; k < 4; ++k) { const f32x2 a = __builtin_amdgcn_cvt_pk_f32_fp8((int)vr[q][c][k], false), b = __builtin_amdgcn_cvt_pk_f32_fp8((int)vr[q][c][k], true); const float w = wv[q];
                    acc[c * 16 + 4 * k] += w * a[0]; acc[c * 16 + 4 * k + 1] += w * a[1]; acc[c * 16 + 4 * k + 2] += w * b[0]; acc[c * 16 + 4 * k + 3] += w * b[1]; }
            asm volatile("" : "+v"(acc[0]), "+v"(acc[1]), "+v"(acc[2]), "+v"(acc[3]), "+v"(acc[4]), "+v"(acc[5]), "+v"(acc[6]), "+v"(acc[7]), "+v"(acc[8]), "+v"(acc[9]), "+v"(acc[10]), "+v"(acc[11]), "+v"(acc[12]), "+v"(acc[13]), "+v"(acc[14]), "+v"(acc[15]));
            asm volatile("" : "+v"(acc[16]), "+v"(acc[17]), "+v"(acc[18]), "+v"(acc[19]), "+v"(acc[20]), "+v"(acc[21]), "+v"(acc[22]), "+v"(acc[23]), "+v"(acc[24]), "+v"(acc[25]), "+v"(acc[26]), "+v"(acc[27]), "+v"(acc[28]), "+v"(acc[29]), "+v"(acc[30]), "+v"(acc[31])); }
    }
    const int r = tok < TL ? (tok >> 11) : 8;
    float* xr = tok < TL ? xl + (size_t)tok * DM : xc + (size_t)(tok - TL) * DM;
    const float* g2 = wsf(p, OFF_MOD) + ((size_t)l * 9 + r) * 12288 + 5 * DM;
#pragma unroll
    for (int c = 0; c < 2; ++c)
#pragma unroll
        for (int k = 0; k < 4; ++k) {
            const int i = c * 1024 + lane * 16 + k * 4;
            f32x4 xa = *(const f32x4*)(xr + i); const f32x4 ga = *(const f32x4*)(g2 + i);
#pragma unroll
            for (int q = 0; q < 4; ++q) xa[q] += ga[q] * acc[c * 16 + k * 4 + q];
            if (commit || xa[0] == 1.2345e30f) *(f32x4*)(xr + i) = xa;
        }
}

DEV void pl_ld_idx(const char* base, unsigned off, u32x4 (&ix)[2]) { ix[0] = *(const u32x4*)(base + off); ix[1] = *(const u32x4*)(base + off + 16u); }
DEV unsigned pl_idx(const u32x4 (&ix)[2], int k) { const unsigned w = ix[k >> 3][(k >> 1) & 3]; return (k & 1) ? (w >> 16) : (w & 0xffffu); }
DEV void pl_ld_rows(const unsigned char* T, unsigned so  , const u32x4 (&ix)[2], u32x4 (&r)[16]) {
#pragma unroll
    for (int k = 0; k < 16; ++k) r[k] = *(const u32x4*)(T + (pl_idx(ix, k) * 128u + so));
}
DEV int red8i(int v) { v += __builtin_amdgcn_update_dpp(0, v, 0xB1, 0xF, 0xF, true); v += __builtin_amdgcn_update_dpp(0, v, 0x4E, 0xF, 0xF, true); v += __builtin_amdgcn_update_dpp(0, v, 0x141, 0xF, 0xF, true); return v; }
DEV int dot16i(const u32x4 w, const u32x4 h) { int s = 0;
#pragma unroll
    for (int k = 0; k < 4; ++k) s = __builtin_amdgcn_sdot4((int)w[k], (int)h[k], s, false);
    return s; }
DEV void pu_compute(const u32x4 (&r)[16], const u32x4 h, char* ppb, unsigned poff, int c8, bool ok) {
    u32x2 o2 = {0u, 0u};
#pragma unroll
    for (int c = 0; c < 8; ++c) { const int da = red8i(dot16i(r[2 * c], h)), db = red8i(dot16i(r[2 * c + 1], h)); if (c8 == c) o2 = (u32x2){(unsigned)da, (unsigned)db}; }
    if (ok) *(u32x2*)(ppb + poff) = o2;
}
DEV void peer_u_pass(const P& p, int l, int MR, int bid, int nb) {
    const int tix = lid(); const int wid = tix >> 6, lane = tix & 63, c8 = lane & 7, pg = lane >> 3;
    const unsigned char* U = (const unsigned char*)wl(p, l, W_U);
    const char* PIL = p.ws + OFF_PIDX; const char* Hb = p.ws + OFF_H8;
    const int xg = bid & 7, rank = bid >> 3, nrank = (nb + 7 - xg) >> 3, stride = nrank * 8, tl = MR - 1;
    const unsigned ioff = (unsigned)(pg * 32);
#pragma unroll 1
    for (int sp = 0; sp < 2; ++sp) {
        const int s = xg + 8 * sp; const unsigned so = (unsigned)(s * (16384 * 128) + c8 * 16);
        char* PPs = p.ws + OFF_SC + (size_t)s * TA * 512;
        const unsigned hoff = (unsigned)(s * 128 + c8 * 16), pofl = (unsigned)(pg * 16 + 2 * c8) * 4u;
        int t = rank * 8 + wid;
        u32x4 ixA[2], ixB[2], rA[16], rB[16], hA, hB;
        { const unsigned tt = (unsigned)min(t, tl); pl_ld_idx(PIL, tt * 256u + ioff, ixA); pl_ld_rows(U, so, ixA, rA); hA = *(const u32x4*)(Hb + (tt * 2048u + hoff)); }
        pl_ld_idx(PIL, (unsigned)min(t + stride, tl) * 256u + ioff, ixB);
#pragma unroll 1
        for (; t < MR; t += 2 * stride) {
            { const unsigned tt = (unsigned)min(t + stride, tl); pl_ld_rows(U, so, ixB, rB); hB = *(const u32x4*)(Hb + (tt * 2048u + hoff)); }
            pl_ld_idx(PIL, (unsigned)min(t + 2 * stride, tl) * 256u + ioff, ixA);
            pu_compute(rA, hA, PPs, (unsigned)t * 512u + pofl, c8, true);
            { const unsigned tt = (unsigned)min(t + 2 * stride, tl); pl_ld_rows(U, so, ixA, rA); hA = *(const u32x4*)(Hb + (tt * 2048u + hoff)); }
            pl_ld_idx(PIL, (unsigned)min(t + 3 * stride, tl) * 256u + ioff, ixB);
            pu_compute(rB, hB, PPs, (unsigned)min(t + stride, tl) * 512u + pofl, c8, t + stride < MR);
        }
    }
}
DEV void peer_mid(const P& p, int l, int MR, int bid, int nb) {
    const int tix = lid();
    const float* US = (const float*)wl(p, l, W_US); const float* VS = (const float*)wl(p, l, W_VS);
    const float* HSC = (const float*)wl(p, l, W_SK);
    const int* PP = (const int*)(p.ws + OFF_SC); const unsigned short* PI = (const unsigned short*)(p.ws + OFF_PIDX); const float* PW = wsf(p, OFF_PW); bf16_t* PWL = (bf16_t*)(p.ws + OFF_ST);
    for (int g4 = bid * 512 + tix; g4 < MR * 32; g4 += nb * 512) {
        const size_t g = (size_t)g4 * 4;
        i32x4 di = {0, 0, 0, 0};
#pragma unroll
        for (int s_ = 0; s_ < 16; ++s_) di += *(const i32x4*)(PP + (size_t)s_ * TA * 128 + g);
        const float hs = HSC[g4 >> 5];
        const f32x4 d = {(float)di[0] * hs, (float)di[1] * hs, (float)di[2] * hs, (float)di[3] * hs};
        const u32x2 iw = *(const u32x2*)(PI + g); const f32x4 gw = *(const f32x4*)(PW + g);
        const unsigned id[4] = {iw.x & 0xffffu, iw.x >> 16, iw.y & 0xffffu, iw.y >> 16}; float wv[4];
#pragma unroll
        for (int q = 0; q < 4; ++q) { const float dd = d[q] * US[id[q]]; const float a = 0.5f * dd * (1.f + erff(dd * 0.70710678118654752f)); wv[q] = a * gw[q] * VS[id[q]]; }
        u32x2 o; o.x = cvtpk(wv[0], wv[1]); o.y = cvtpk(wv[2], wv[3]);
        *(u32x2*)(PWL + g) = o;
    }
}
DEV float swsum32(float a, float b) { auto r = __builtin_amdgcn_permlane32_swap(__float_as_uint(a), __float_as_uint(b), false, false); return __uint_as_float(r[0]) + __uint_as_float(r[1]); }
DEV float swsum16(float a, float b) { auto r = __builtin_amdgcn_permlane16_swap(__float_as_uint(a), __float_as_uint(b), false, false); return __uint_as_float(r[0]) + __uint_as_float(r[1]); }
template <int HALF> DEV void pl_ld_rows_h(const unsigned char* T, unsigned so, const u32x4 (&ix)[2], u32x4 (&r)[16]) {
#pragma unroll
    for (int k = HALF * 8; k < HALF * 8 + 8; ++k) r[k] = *(const u32x4*)(T + (pl_idx(ix, k) * 128u + so));
}
template <int HALF> DEV void pv_half(const u32x4 (&vr)[16], const u32x4 w8  , f32x2 (&acc)[16]) {
#pragma unroll
    for (int k = 0; k < 8; ++k) { const unsigned ww = w8[(k >> 1) & 3]; const float w = (k & 1) ? bfhi(ww) : bflo(ww); const f32x2 w2 = {w, w};
#pragma unroll
        for (int d4 = 0; d4 < 4; ++d4) { const unsigned q = vr[HALF * 8 + k][d4];
            acc[d4 * 4 + 0] = __builtin_amdgcn_cvt_scalef32_pk_f32_fp4(q, 1.0f, 0) * w2 + acc[d4 * 4 + 0]; acc[d4 * 4 + 1] = __builtin_amdgcn_cvt_scalef32_pk_f32_fp4(q, 1.0f, 1) * w2 + acc[d4 * 4 + 1];
            acc[d4 * 4 + 2] = __builtin_amdgcn_cvt_scalef32_pk_f32_fp4(q, 1.0f, 2) * w2 + acc[d4 * 4 + 2]; acc[d4 * 4 + 3] = __builtin_amdgcn_cvt_scalef32_pk_f32_fp4(q, 1.0f, 3) * w2 + acc[d4 * 4 + 3]; }
        asm volatile("" : "+v"(acc[0]), "+v"(acc[1]), "+v"(acc[2]), "+v"(acc[3]), "+v"(acc[4]), "+v"(acc[5]), "+v"(acc[6]), "+v"(acc[7]),
                          "+v"(acc[8]), "+v"(acc[9]), "+v"(acc[10]), "+v"(acc[11]), "+v"(acc[12]), "+v"(acc[13]), "+v"(acc[14]), "+v"(acc[15]));
    }
}
DEV void pv_finish(const P& p, int l, const f32x2 (&acc)[16], int t, int s, int c8, int pg, bf16_t* xb, float* outf  , bool ok) {
    f32x2 c1[8], c2[4], c3[2];
#pragma unroll
    for (int m = 0; m < 8; ++m) { c1[m][0] = swsum32(acc[m][0], acc[8 + m][0]); c1[m][1] = swsum32(acc[m][1], acc[8 + m][1]); }
#pragma unroll
    for (int m = 0; m < 4; ++m) { c2[m][0] = swsum16(c1[m][0], c1[4 + m][0]); c2[m][1] = swsum16(c1[m][1], c1[4 + m][1]); }
    const bool b3 = (pg & 1) != 0;
#pragma unroll
    for (int m = 0; m < 2; ++m)
#pragma unroll
        for (int e = 0; e < 2; ++e) { const float keep = b3 ? c2[2 + m][e] : c2[m][e], send = b3 ? c2[m][e] : c2[2 + m][e]; c3[m][e] = keep + dppf<0x128>(send); }
    if (ok) {
        const int r = t < TL ? (t >> 11) : 8;
        const size_t eo = (size_t)t * DM + s * 256 + c8 * 32 + pg * 4;
        const f32x4 ga = *(const f32x4*)(wsf(p, OFF_MOD) + ((size_t)l * 9 + r) * 12288 + 5 * DM + s * 256 + c8 * 32 + pg * 4);
        const u32x2 xw = *(const u32x2*)(xb + eo);
        const float y0 = bflo(xw.x) + ga[0] * c3[0][0], y1 = bfhi(xw.x) + ga[1] * c3[0][1], y2 = bflo(xw.y) + ga[2] * c3[1][0], y3 = bfhi(xw.y) + ga[3] * c3[1][1];
        if (outf) *(f32x4*)(outf + eo) = (f32x4){y0, y1, y2, y3};
        else { u32x2 o; o.x = cvtpk(y0, y1); o.y = cvtpk(y2, y3); *(u32x2*)(xb + eo) = o; }
    }
}
DEV void peer_v_pass(const P& p, int l, int MR, bf16_t* xb, float* outf, int bid, int nb, bool commit) {
    const int tix = lid(); const int wid = tix >> 6, lane = tix & 63, c8 = lane & 7, pg = lane >> 3;
    const unsigned char* V = (const unsigned char*)wl(p, l, W_V);
    const char* PIL = p.ws + OFF_PIDX; const char* PWL = p.ws + OFF_ST;
    const int xg = bid & 7, rank = bid >> 3, nrank = (nb + 7 - xg) >> 3, stride = nrank * 8, tl = MR - 1;
    const unsigned ioff = (unsigned)(pg * 32);
    {
        const int s = xg; const unsigned so = (unsigned)(s * (16384 * 128) + c8 * 16);
        int t = rank * 8 + wid;
#define PV_TT(d) ((unsigned)min(t + (d) * stride, tl))
        u32x4 ixA[2], ixB[2], rA[16], rB[16], wA0, wA1, wB0, wB1;
        pl_ld_idx(PIL, PV_TT(0) * 256u + ioff, ixA); pl_ld_idx(PIL, PV_TT(1) * 256u + ioff, ixB);
        pl_ld_rows_h<0>(V, so, ixA, rA); pl_ld_rows_h<1>(V, so, ixA, rA); wA0 = *(const u32x4*)(PWL + (PV_TT(0) * 256u + ioff)); wA1 = *(const u32x4*)(PWL + (PV_TT(0) * 256u + ioff + 16u));
        pl_ld_rows_h<0>(V, so, ixB, rB); pl_ld_rows_h<1>(V, so, ixB, rB); wB0 = *(const u32x4*)(PWL + (PV_TT(1) * 256u + ioff)); wB1 = *(const u32x4*)(PWL + (PV_TT(1) * 256u + ioff + 16u));
        pl_ld_idx(PIL, PV_TT(2) * 256u + ioff, ixA);
#pragma unroll 1
        for (; t < MR; t += 2 * stride) {
            f32x2 acc[16];
#pragma unroll
            for (int j = 0; j < 16; ++j) acc[j] = (f32x2){0.f, 0.f};
            pv_half<0>(rA, wA0, acc);
            pl_ld_rows_h<0>(V, so, ixA, rA);
            pl_ld_idx(PIL, PV_TT(3) * 256u + ioff, ixB);
            pv_half<1>(rA, wA1, acc);
            pl_ld_rows_h<1>(V, so, ixA, rA);
            pv_finish(p, l, acc, t, s, c8, pg, xb, outf, commit);
            wA0 = *(const u32x4*)(PWL + (PV_TT(2) * 256u + ioff)); wA1 = *(const u32x4*)(PWL + (PV_TT(2) * 256u + ioff + 16u));
#pragma unroll
            for (int j = 0; j < 16; ++j) acc[j] = (f32x2){0.f, 0.f};
            pv_half<0>(rB, wB0, acc);
            pl_ld_rows_h<0>(V, so, ixB, rB);
            pl_ld_idx(PIL, PV_TT(4) * 256u + ioff, ixA);
            pv_half<1>(rB, wB1, acc);
            pl_ld_rows_h<1>(V, so, ixB, rB);
            pv_finish(p, l, acc, (int)PV_TT(1), s, c8, pg, xb, outf, commit && (t + stride < MR));
            wB0 = *(const u32x4*)(PWL + (PV_TT(3) * 256u + ioff)); wB1 = *(const u32x4*)(PWL + (PV_TT(3) * 256u + ioff + 16u));
        }
#undef PV_TT
    }
}

#define XB_TMO      128
#define XB_XCNT(j)  (256  + 64 * (j))
#define XB_XSUB(j)  (1280 + 64 * (j))
#define XB_XGEN(j)  (2304 + 64 * (j))
#define XB_TOP      3328
#define XB_TOPGEN   3392
#define XCD_BAR_WORDS 3456
#define XB_SPIN_CAP (1u << 20)
DEV unsigned xb_ld(unsigned* p)              { return __hip_atomic_load(p, __ATOMIC_RELAXED, __HIP_MEMORY_SCOPE_AGENT); }
DEV unsigned xb_add(unsigned* p, unsigned v) { return __hip_atomic_fetch_add(p, v, __ATOMIC_RELAXED, __HIP_MEMORY_SCOPE_AGENT); }
DEV unsigned xb_xcc_id() { return (unsigned)__builtin_amdgcn_s_getreg((3 << 11) | 20) & 0xFu; }
#define XB_SPIN(cond, bar) do { unsigned _sp = 0; while (cond) { __builtin_amdgcn_s_sleep(1); \
    if ((++_sp & 255u) == 0u) { if (xb_ld(&(bar)[XB_TMO])) break; if (_sp > XB_SPIN_CAP) { atomicAdd(&(bar)[XB_TMO], 1u); break; } } } } while (0)
struct XcdBarrier { unsigned* bar; unsigned x; volatile LAS unsigned* st; };
DEV XcdBarrier xcd_barrier_post(unsigned* bar, volatile LAS unsigned* st) {
    XcdBarrier b; b.bar = bar; b.x = xb_xcc_id(); b.st = st;
    if (lid() == 0) (void)xb_add(&bar[XB_XCNT(b.x)], 1u);
    return b;
}
DEV void xcd_barrier_complete(unsigned* bar, unsigned x, unsigned& nloc, unsigned& nx) {
    const unsigned G = gridDim.x * gridDim.y * gridDim.z;
    unsigned sum, cnt, mine, sp = 0u;
    for (;;) {
        sum = 0u; cnt = 0u; mine = 0u;
#pragma unroll
        for (unsigned j = 0; j < 16; ++j) { const unsigned c = xb_ld(&bar[XB_XCNT(j)]); sum += c; cnt += (c > 0u) ? 1u : 0u; mine = (j == x) ? c : mine; }
        if (sum == G) break;
        __builtin_amdgcn_s_sleep(1);
        if ((++sp & 255u) == 0u) { if (xb_ld(&bar[XB_TMO])) break; if (sp > XB_SPIN_CAP) { atomicAdd(&bar[XB_TMO], 1u); break; } }
    }
    nloc = mine > 0u ? mine : 1u; nx = cnt > 0u ? cnt : 1u;
}
DEV void xcd_barrier(const XcdBarrier& b) {
    asm volatile("s_waitcnt vmcnt(0)" ::: "memory");
    __syncthreads();
    if (lid() == 0) {
        unsigned* bar = b.bar;
        const unsigned bx = __builtin_amdgcn_readfirstlane(xb_xcc_id());
        __builtin_amdgcn_s_waitcnt(0);
        unsigned nloc = b.st[0], nx = b.st[1];
        if (nloc == 0u) { xcd_barrier_complete(bar, bx, nloc, nx); b.st[0] = nloc; b.st[1] = nx; }
        const unsigned old = xb_add(&bar[XB_XSUB(bx)], 1u);
        const unsigned gen = old / nloc;
        if (old + 1u == (gen + 1u) * nloc) {
            __builtin_amdgcn_fence(__ATOMIC_RELEASE, "agent");
            asm volatile("s_waitcnt vmcnt(0)" ::: "memory");
            const unsigned og = xb_add(&bar[XB_TOP], 1u);
            const unsigned tg = og / nx;
            if (og + 1u == (tg + 1u) * nx) xb_add(&bar[XB_TOPGEN], 1u);
            else XB_SPIN(xb_ld(&bar[XB_TOPGEN]) == tg, bar);
            __builtin_amdgcn_fence(__ATOMIC_ACQUIRE, "agent");
            xb_add(&bar[XB_XGEN(bx)], 1u);
            asm volatile("s_waitcnt vmcnt(0)" ::: "memory");
        } else {
            XB_SPIN(xb_ld(&bar[XB_XGEN(bx)]) == gen, bar);
            __builtin_amdgcn_fence(__ATOMIC_ACQUIRE, "agent");
            asm volatile("s_waitcnt vmcnt(0)" ::: "memory");
        }
    }
    __syncthreads();
}

enum { PH_PRO = 0, PH_NORM1, PH_PROJ, PH_PREP1, PH_UP, PH_PREP2, PH_MIX, PH_Z, PH_G, PH_O, PH_NORM2, PH_PQ, PH_PSC, PH_PTK, PH_PGA, PH_PU, PH_PM, PH_PV, PH_COUNT };

template <int PH>
DEV void run_phase(const P& p_, const int l, char* smem, const int bid, const int nb, const bool commit = true) {
    P p = p_;
#if defined(__HIP_DEVICE_COMPILE__)
    {   typedef __attribute__((address_space(4))) const P CP; typedef __attribute__((address_space(1))) char gch;
        CP* pp = (CP*)__builtin_amdgcn_kernarg_segment_ptr(); asm volatile("" : "+s"(pp)); (void)p_;
#define GLB(f) p.f = (decltype(p.f))(gch*)(pp->f)
        GLB(x); GLB(c); GLB(ctx); GLB(c_ctx); GLB(w_mod); GLB(b_mod); GLB(norm1_g); GLB(norm2_g); GLB(w_in); GLB(diff_lambda); GLB(diff_qk_g); GLB(diff_sub_g); GLB(ret_decay); GLB(ret_norm_g);
        GLB(na_qk_g); GLB(na_rpb); GLB(mla_q_norm_g); GLB(mla_kv_norm_g); GLB(w_uq); GLB(w_ukv); GLB(mla_qk_g); GLB(w_branch); GLB(w_gate); GLB(b_gate); GLB(w_o); GLB(peer_w_query); GLB(peer_sub_keys);
        GLB(peer_u); GLB(peer_v); GLB(out); GLB(ws);
#undef GLB
    }
#endif
    const bool last = (l == 1);
    int MR = last ? TL : TA;
    asm volatile("" : "+s"(MR));
    bf16_t* xb = wsb(p, OFF_XB);
    const float* mod = wsf(p, OFF_MOD) + (size_t)l * 9 * 12288;
    if constexpr (PH == PH_PRO) { phase_prologue(p, smem, bid, nb); }
    if constexpr (PH == PH_NORM1) {
        constexpr bool NEED_BF16 = !PROJ_FP8 || ((0xFFFFFFu & ~PROJ_F8_MASK) != 0u);
        phase_norm(p.x, p.ctx, p.norm1_g + l * DM, mod, 0, 1, NEED_BF16 ? wsb(p, OFF_H) : nullptr, TA, bid, nb, (unsigned char*)(p.ws + OFF_H8), nullptr, nullptr, l == 0 ? nullptr : xb); }
    if constexpr (PH == PH_PROJ) {
        constexpr unsigned M8 = PROJ_FP8 ? (PROJ_F8_MASK & 0xFFFFFFu) : 0u, M16 = 0xFFFFFFu & ~M8;
        if constexpr (M8 != 0u) { g8::EpiBf16 e{wsb(p, OFF_PROJ), INP, 0, commit, 1.f / 256.f};
            g8::gemm_stream_f8<DM, false>((const unsigned char*)(p.ws + OFF_H8), (const unsigned char*)wl(p, l, W_IN8), g8::Order{TA / 256, __builtin_popcount(M8), 1, nb, bid, M8, STAG_PROJ}, e, smem); }
        if constexpr (M16 != 0u) { g8::EpiBf16 e{wsb(p, OFF_PROJ), INP, 0, commit};
            g8::gemm_stream<DM, DM, true>(wsb(p, OFF_H), 0, wl(p, l, W_IN), 0, g8::Order{TA / 256, __builtin_popcount(M16), 1, nb, bid, M16}, e, smem); }
    }
    if constexpr (PH == PH_PREP1) { phase_prep1(p, l, bid, nb); }
    if constexpr (PH == PH_UP) {
        { g8::EpiBf16 e{wsb(p, OFF_QM), 768, 0}; g8::gemm_stream<INP, 512, true>(wsb(p, OFF_PROJ) + C_MCQ, 0, wl(p, l, W_UQ), 0, g8::Order{TA / 256, 3, 1, nb, bid}, e, smem); }
        { g8::EpiBf16 e{wsb(p, OFF_KVM), 1024, 0}; g8::gemm_stream<INP, 256, true>(wsb(p, OFF_PROJ) + C_MKV, 0, wl(p, l, W_UKV), 0, g8::Order{TA / 256, 4, 1, nb, bid}, e, smem); }
        for (int u = (bid + nb - 192 % nb) % nb; u < 576; u += nb) rts_unit(p, l, u & 7, (u >> 3) & 3, u >> 5, smem);
    }
    if constexpr (PH == PH_PREP2) { phase_prep2(p, l, bid, nb); phase_rtp(p, l, bid, nb); }
    if constexpr (PH == PH_MIX) {
#ifndef PROBE_MIX
#define PROBE_MIX -1
#endif
#pragma unroll 1
        for (int rp = 0; rp < (PROBE_MIX == 0 ? 2 : 1); ++rp)
        for (int u = bid; u < 256; u += nb) mla_unit(p, u & 7, (u >> 3) & 3, (u & 7) * SEQ + (u >> 5) * 256, false, smem);
#pragma unroll 1
        for (int rp = 0; rp < (PROBE_MIX == 1 ? 2 : 1); ++rp)
        for (int u = bid; u < 512; u += nb) da_unit(p, l, u & 7, (u >> 3) & 3, (u & 7) * SEQ + (u >> 5) * 128, false, smem);
#pragma unroll 1
        for (int rp = 0; rp < (PROBE_MIX == 2 ? 2 : 1); ++rp)
        for (int u = bid; u < 512; u += nb) na_unit(p, l, u & 7, (u >> 3) & 31, u >> 8, false, smem);
#pragma unroll 1
        for (int rp = 0; rp < (PROBE_MIX == 3 ? 2 : 1); ++rp)
        for (int u = bid; u < 512; u += nb) rto_unit(p, l, u & 7, (u >> 3) & 3, 2 + (u >> 5), smem);
        if (!last) {
            for (int u = bid; u < 32; u += nb) mla_unit(p, u & 7, (u >> 3) & 3, TL + (u & 7) * CTX, true, smem);
            for (int u = (bid + nb - 32 % nb) % nb; u < 64; u += nb) da_unit(p, l, u & 7, (u >> 3) & 3, TL + (u & 7) * CTX + (u >> 5) * 128, true, smem);
            for (int u = (bid + nb - 96 % nb) % nb; u < 64; u += nb) na_unit(p, l, u & 7, (u >> 3) & 3, u >> 5, true, smem);
            for (int u = (bid + nb - 160 % nb) % nb; u < 64; u += nb) rto_unit(p, l, u & 7, (u >> 3) & 3, u >> 5, smem);
        }
    }
    if constexpr (PH == PH_Z) {
        g8::EpiBf16 e{wsb(p, OFF_Z), 8192, 2048};
        g8::gemm_stream<DM, 512, true>(wsb(p, OFF_Y), 512, wl(p, l, W_B), (size_t)DM * 512, g8::Order{MR / 256, 8, 4, nb, bid, 0u, STAG_Z}, e, smem);
    }
    if constexpr (PH == PH_G) { g8::EpiMerge e{wsb(p, OFF_M), wsb(p, OFF_Z), p.b_gate + (size_t)l * 4 * DM, 1.f / 256.f}; g8::gemm_stream_f8<DM, false>((const unsigned char*)(p.ws + OFF_H8), (const unsigned char*)wl(p, l, W_G), g8::Order{MR / 256, 32, 1, nb, bid, 0u, STAG_G}, e, smem); }
    if constexpr (PH == PH_O) {
        if (l == 0) { g8::EpiResidB<false> e{p.x, p.ctx, xb, mod + 2 * DM}; g8::gemm_stream<DM, DM, true>(wsb(p, OFF_M), 0, wl(p, l, W_O), 0, g8::Order{MR / 256, 8, 1, nb, bid}, e, smem); }
        else { g8::EpiResidB<true> e{p.x, p.ctx, xb, mod + 2 * DM}; g8::gemm_stream<DM, DM, true>(wsb(p, OFF_M), 0, wl(p, l, W_O), 0, g8::Order{MR / 256, 8, 1, nb, bid}, e, smem); }
    }
    if constexpr (PH == PH_NORM2) { phase_norm(p.x, p.ctx, p.norm2_g + l * DM, mod, 3, 4, wsb(p, OFF_H), MR, bid, nb, nullptr, (unsigned char*)(p.ws + OFF_H8), (float*)wl(p, l, W_SK), xb); }
    if constexpr (PH == PH_PQ) { g8::EpiScoresT e{wsf(p, OFF_SC)}; g8::gemm_stream<DM, DM, false, g8::EpiScoresT, false>(wsb(p, OFF_H), 0, wl(p, l, W_Q), 0, g8::Order{MR / 256, 8, 1, nb, bid}, e, smem); }
    if constexpr (PH == PH_PSC) { peer_scores_phase(p, l, (MR / 256) * 16, bid, nb); }
    if constexpr (PH == PH_PTK) { for (int u = bid * 8 + (lid() >> 6); u < (MR / 64) * 8; u += nb * 8) peer_topk_task(p, u & 7, (u >> 3) * 64, smem); }
    if constexpr (PH == PH_PU) { peer_u_pass(p, l, MR, bid, nb); }
    if constexpr (PH == PH_PM) { peer_mid(p, l, MR, bid, nb); }
    if constexpr (PH == PH_PV) { peer_v_pass(p, l, MR, xb, last ? p.out : nullptr, bid, nb, commit); }
}

constexpr int LDS_BYTES = 131072 + 16 + 256;

#if !MK_ONE_LAUNCH
template <int PH>
__global__ void __launch_bounds__(512, 2) k_phase(P p, int l) {
    extern __shared__ __attribute__((aligned(16))) char smem[];
    lid_init();
    run_phase<PH>(p, l, smem, blockIdx.x, gridDim.x);
}
template <int PH> static void launch_phase(const P& p, int l, hipStream_t st) {
    static bool attr = false;
    if (!attr) { hipFuncSetAttribute((const void*)k_phase<PH>, hipFuncAttributeMaxDynamicSharedMemorySize, LDS_BYTES); attr = true; }
    hipLaunchKernelGGL(k_phase<PH>, dim3(256), dim3(512), LDS_BYTES, st, p, l);
}
#else
template <int PH> DEV void phase_and_barrier(const P& p, int l, char* smem, const XcdBarrier& bar, bool final_phase = false) {
    constexpr int NREP = (PH == PROBE_PH) ? PROBE_N : 1;
#pragma unroll 1
    for (int rep = 0; rep < NREP; ++rep) {
        run_phase<PH>(p, l, smem, blockIdx.x, gridDim.x, rep == NREP - 1);
        if (!(final_phase && rep == NREP - 1)) xcd_barrier(bar);
    }
}
__global__ void __launch_bounds__(512, 2) k_mega(P p) {
    extern __shared__ __attribute__((aligned(16))) char smem[];
    uint4* xbw = (uint4*)(smem + 131072);
    if (threadIdx.x == 0) *xbw = make_uint4(0u, 0u, 0u, 0u);
    lid_init();
    XcdBarrier bar = xcd_barrier_post((unsigned*)(p.ws + OFF_BAR), (volatile LAS unsigned*)xbw);
    phase_and_barrier<PH_PRO>(p, 0, smem, bar);
    for (int l = 0; l < 2; ++l) {
        phase_and_barrier<PH_NORM1>(p, l, smem, bar);
        phase_and_barrier<PH_PROJ>(p, l, smem, bar);
        phase_and_barrier<PH_PREP1>(p, l, smem, bar);
        phase_and_barrier<PH_UP>(p, l, smem, bar);
        phase_and_barrier<PH_PREP2>(p, l, smem, bar);
        phase_and_barrier<PH_MIX>(p, l, smem, bar);
        phase_and_barrier<PH_Z>(p, l, smem, bar);
        phase_and_barrier<PH_G>(p, l, smem, bar);
        phase_and_barrier<PH_O>(p, l, smem, bar);
        phase_and_barrier<PH_NORM2>(p, l, smem, bar);
        phase_and_barrier<PH_PQ>(p, l, smem, bar);
        phase_and_barrier<PH_PTK>(p, l, smem, bar);
        phase_and_barrier<PH_PU>(p, l, smem, bar);
        phase_and_barrier<PH_PM>(p, l, smem, bar);
        phase_and_barrier<PH_PV>(p, l, smem, bar, l == 1);
    }
}
#endif

extern "C" void kernel_launch(void* const* d_in, const int* in_sizes, int n_in, void* d_out, int out_size, void* d_ws, size_t ws_size, hipStream_t stream) {
    if (n_in != 29 || ws_size < WS_NEED) { fprintf(stderr, "kernel_launch: bad args n_in=%d ws=%zu need=%zu\n", n_in, ws_size, (size_t)WS_NEED); return; }
    P p{};
    const float** f = (const float**)&p;
    for (int i = 0; i < 29; ++i) f[i] = (const float*)d_in[i];
    p.out = (float*)d_out; p.ws = (char*)d_ws;
#if !MK_ONE_LAUNCH
    launch_phase<PH_PRO>(p, 0, stream);
    for (int l = 0; l < 2; ++l) {
        launch_phase<PH_NORM1>(p, l, stream); launch_phase<PH_PROJ>(p, l, stream); launch_phase<PH_PREP1>(p, l, stream); launch_phase<PH_UP>(p, l, stream);
        launch_phase<PH_PREP2>(p, l, stream); launch_phase<PH_MIX>(p, l, stream); launch_phase<PH_Z>(p, l, stream); launch_phase<PH_G>(p, l, stream);
        launch_phase<PH_O>(p, l, stream); launch_phase<PH_NORM2>(p, l, stream); launch_phase<PH_PQ>(p, l, stream);
        launch_phase<PH_PTK>(p, l, stream); launch_phase<PH_PU>(p, l, stream); launch_phase<PH_PM>(p, l, stream); launch_phase<PH_PV>(p, l, stream);
    }
#else
    static int grid = 0;
    if (!grid) {
        hipFuncSetAttribute((const void*)k_mega, hipFuncAttributeMaxDynamicSharedMemorySize, LDS_BYTES);
        int dev = 0, cus = 0, per_cu = 0; hipGetDevice(&dev); hipDeviceGetAttribute(&cus, hipDeviceAttributeMultiprocessorCount, dev);
        hipOccupancyMaxActiveBlocksPerMultiprocessor(&per_cu, (const void*)k_mega, 512, LDS_BYTES);
        grid = cus * (per_cu < 1 ? per_cu : 1);
        if (grid <= 0) { fprintf(stderr, "kernel_launch: occupancy query says %d blocks/CU\n", per_cu); grid = 0; return; }
    }
    hipMemsetAsync((char*)d_ws + OFF_BAR, 0, 16384, stream);
    hipLaunchKernelGGL(k_mega, dim3(grid), dim3(512), LDS_BYTES, stream, p);
#endif
    const hipError_t le = hipPeekAtLastError();
    if (le != hipSuccess) fprintf(stderr, "kernel_launch: launch failed: %s\n", hipGetErrorName(le));
}
```

```cpp
#include <hip/hip_runtime.h>
#include <cstdio>
#include <cstdint>

#ifndef MK_ONE_LAUNCH
#define MK_ONE_LAUNCH 1
#endif
#ifndef PEER_SLICED
#define PEER_SLICED 1
#endif
#ifndef PROJ_FP8
#define PROJ_FP8 1
#endif
#ifndef PROJ_F8_MASK
#define PROJ_F8_MASK 0xFFFFFFu
#endif
#define PROJ_BF16_TILES ((PROJ_FP8 ? (0xFFFFFFu & ~(PROJ_F8_MASK)) : 0xFFFFFFu) != 0u)
#ifndef STAG_PROJ
#define STAG_PROJ 0
#define STAG_Z 0
#define STAG_G 0
#endif
#ifndef PROBE_PH
#define PROBE_PH -1
#endif
#ifndef PROBE_N
#define PROBE_N 1
#endif

typedef unsigned short bf16_t;
typedef short bf16x8 __attribute__((ext_vector_type(8)));
typedef short s16x4 __attribute__((ext_vector_type(4)));
typedef float f32x4 __attribute__((ext_vector_type(4)));
typedef float f32x2 __attribute__((ext_vector_type(2)));
typedef float f32x16 __attribute__((ext_vector_type(16)));
typedef unsigned u32x4 __attribute__((ext_vector_type(4)));
typedef int i32x4 __attribute__((ext_vector_type(4)));
typedef unsigned u32x2 __attribute__((ext_vector_type(2)));
#define DEV __device__ __forceinline__
#define LAS __attribute__((address_space(3)))

typedef __bf16 bf16v2_t __attribute__((ext_vector_type(2)));
DEV unsigned cvtpk_v(float lo, float hi) { const f32x2 v = {lo, hi}; return __builtin_bit_cast(unsigned, __builtin_convertvector(v, bf16v2_t)); }
DEV unsigned cvtpk(float lo, float hi) { unsigned r; asm volatile("v_cvt_pk_bf16_f32 %0, %1, %2" : "=v"(r) : "v"(lo), "v"(hi)); return r; }
DEV float bf2f(bf16_t x) { return __uint_as_float(((unsigned)x) << 16); }
DEV float bflo(unsigned w) { return __uint_as_float(w << 16); }
DEV float bfhi(unsigned w) { return __uint_as_float(w & 0xffff0000u); }
DEV bf16_t f2bf(float x) { return (bf16_t)(cvtpk(x, x) & 0xffffu); }
template <int CTRL> DEV float dppf(float v) { return __uint_as_float((unsigned)__builtin_amdgcn_update_dpp(0, (int)__float_as_uint(v), CTRL, 0xF, 0xF, true)); }
DEV float red8(float v) { v += dppf<0xB1>(v); v += dppf<0x4E>(v); v += dppf<0x141>(v); return v; }
template <int MASK> DEV float xshf(float v) {
    if constexpr (MASK == 1) return dppf<0xB1>(v);
    else if constexpr (MASK == 2) return dppf<0x4E>(v);
    else if constexpr (MASK == 8) return dppf<0x128>(v);
    else if constexpr (MASK == 32) { const unsigned u = __float_as_uint(v); auto r = __builtin_amdgcn_permlane32_swap(u, u, false, false); return __uint_as_float(r[0] ^ r[1] ^ u); }
    else return __uint_as_float((unsigned)__builtin_amdgcn_ds_swizzle((int)__float_as_uint(v), (MASK << 10) | 0x1F));
}
DEV float wave_sum(float v) {
    v += xshf<1>(v); v += xshf<2>(v); v += xshf<4>(v); v += xshf<8>(v); v += xshf<16>(v);
    { auto r = __builtin_amdgcn_permlane32_swap(__float_as_uint(v), __float_as_uint(v), false, false); v = __uint_as_float(r[0]) + __uint_as_float(r[1]); }
    return v;
}
extern __shared__ __attribute__((aligned(16))) char g_smem[];
constexpr int LDS_WTAB = 131072 + 16;
DEV int hw_slot() { return __builtin_amdgcn_s_getreg((5 << 11) | 4) & 63; }
DEV void lid_init() { if ((threadIdx.x & 63) == 0) ((LAS int*)(g_smem + LDS_WTAB))[hw_slot()] = (int)(threadIdx.x >> 6); __syncthreads(); }
DEV int lid() { const int w = __builtin_amdgcn_readfirstlane(((const LAS int*)(g_smem + LDS_WTAB))[hw_slot()]);
    int ln; asm volatile("v_mbcnt_lo_u32_b32 %0, -1, 0\n\tv_mbcnt_hi_u32_b32 %0, -1, %0" : "=v"(ln));
    return (w << 6) | ln; }
DEV int at_crow(int r, int hi) { return (r & 3) + 8 * (r >> 2) + 4 * hi; }
DEV float sigmoidf_(float x) { return __builtin_amdgcn_rcpf(1.f + __expf(-x)); }
DEV float siluf_(float x) { return x * __builtin_amdgcn_rcpf(1.f + __expf(-x)); }

constexpr int TL = 16384, TC = 2048, TA = 18432, DM = 2048, INW = 5952, INP = 6144;
constexpr int NB = 8, SEQ = 2048, CTX = 256;
constexpr float EPS = 1e-6f;
constexpr int C_DAQ = 0, C_DAK = 512, C_DAV = 1024, C_RTQ = 1536, C_RTK = 2048, C_RTV = 2560, C_RTG = 3072;
constexpr int C_NAQ = 3584, C_NAK = 4096, C_NAV = 4608, C_MCQ = 5120, C_MKV = 5632, C_MKR = 5888;

constexpr size_t AL(size_t x) { return (x + 255) / 256 * 256; }
constexpr size_t OFF_BAR = 0;
constexpr size_t OFF_MOD = 16384;
constexpr size_t SZ_MOD = (size_t)2 * 9 * 12288 * 4;
constexpr size_t OFF_ROPEA = AL(OFF_MOD + SZ_MOD);
constexpr size_t OFF_ROPER = OFF_ROPEA + 2 * 64 * 16 * 4;
constexpr size_t OFF_MISC = OFF_ROPER + 2 * 64 * 32 * 4;
constexpr size_t OFF_XC = 1u << 20;
constexpr size_t OFF_H = OFF_XC + (size_t)TC * DM * 4;
constexpr size_t OFF_PROJ = OFF_H + (size_t)TA * DM * 2;
constexpr size_t OFF_QM = OFF_PROJ + (size_t)TA * INP * 2;
constexpr size_t OFF_KVM = OFF_QM + (size_t)TA * 768 * 2;
constexpr size_t OFF_KM = OFF_KVM + (size_t)TA * 1024 * 2;
constexpr size_t OFF_Y = OFF_KM + (size_t)TA * 768 * 2;
constexpr size_t OFF_M = OFF_Y + (size_t)TA * DM * 2;
constexpr size_t OFF_ST = OFF_M + (size_t)TA * DM * 2;
constexpr size_t OFF_RT = OFF_ST + (size_t)1152 * 16384 * 4;
constexpr size_t OFF_PIDX = OFF_RT + (size_t)1152 * 16384 * 2;
constexpr size_t OFF_PW = OFF_PIDX + (size_t)TA * 128 * 4;
constexpr size_t OFF_W = OFF_PW + (size_t)TA * 128 * 4;
constexpr size_t OFF_Z = OFF_PROJ;
constexpr size_t OFF_SC = OFF_PROJ;
constexpr size_t OFF_QP = OFF_Y;
static_assert((size_t)TA * 8192 * 2 <= OFF_Y - OFF_PROJ, "Z overlay");
static_assert((size_t)16 * 128 * TA * 4 <= OFF_Y - OFF_PROJ, "SC overlay");
constexpr size_t W_IN = 0;
constexpr size_t W_G = W_IN + (size_t)INP * DM * 2;
constexpr size_t W_B = W_G + (size_t)8192 * DM;
constexpr size_t W_O = W_B + (size_t)4 * 2048 * 512 * 2;
constexpr size_t W_Q = W_O + (size_t)DM * DM * 2;
constexpr size_t W_UQ = W_Q + (size_t)DM * DM * 2;
constexpr size_t W_UKV = W_UQ + (size_t)768 * 512 * 2;
constexpr size_t W_SK = W_UKV + (size_t)1024 * 256 * 2;
constexpr size_t W_U = W_SK + (size_t)262144 * 2;
constexpr size_t W_V = W_U + (size_t)16384 * DM;
constexpr size_t W_US = W_V + (size_t)16384 * DM;
constexpr size_t W_VS = W_US + 65536;
constexpr size_t W_IN8 = W_VS + 65536;
constexpr size_t W_LAYER = W_IN8 + (size_t)INP * DM;
constexpr size_t OFF_H8 = OFF_W + 2 * W_LAYER;
constexpr size_t OFF_XB = OFF_H8 + (size_t)TA * DM;
constexpr size_t WS_NEED = OFF_XB + (size_t)TA * DM * 2;

struct P {
    const float *x, *c, *ctx, *c_ctx, *w_mod, *b_mod, *norm1_g, *norm2_g, *w_in, *diff_lambda, *diff_qk_g, *diff_sub_g, *ret_decay, *ret_norm_g,
        *na_qk_g, *na_rpb, *mla_q_norm_g, *mla_kv_norm_g, *w_uq, *w_ukv, *mla_qk_g, *w_branch, *w_gate, *b_gate, *w_o, *peer_w_query, *peer_sub_keys,
        *peer_u, *peer_v;
    float* out;
    char* ws;
};
DEV bf16_t* wsb(const P& p, size_t off) { return (bf16_t*)(p.ws + off); }
DEV float* wsf(const P& p, size_t off) { return (float*)(p.ws + off); }
DEV bf16_t* wl(const P& p, int l, size_t off) { return (bf16_t*)(p.ws + OFF_W + (size_t)l * W_LAYER + off); }

namespace g8 {
constexpr int BM = 256, BK = 64, HALF = 128, HTB = HALF * BK * 2, SHM_B = 8 * HTB;
DEV int lds_byte(int r, int c) { int st = (r >> 4) * 2 + (c >> 5), rr = r & 15, cc = c & 31, ob = rr * 64 + cc * 2; return st * 1024 + (ob ^ (((ob >> 9) & 1) << 5)); }
DEV void stage_rc(int b, int& R, int& C) { int st = b / 1024, sb = b % 1024, swz = sb ^ (((sb >> 9) & 1) << 5); R = (st >> 1) * 16 + swz / 64; C = (st & 1) * 32 + (swz % 64) / 2; }
DEV int perm32(int rho) { const int n = rho >> 4, i = rho & 15; return 8 * (i >> 2) + 4 * n + (i & 3); }
struct Unit { int pm, pn, g; };
struct Order {
    int nM, nN, NG, G, c; unsigned cmask = 0u;
    int stagger = 0;
    DEV bool next(int i, Unit& u) const {
        const int per = nM * nN; const long L = (long)i * G + c; if (L >= (long)per * NG) return false;
        u.g = (int)(L / per); int wgid = (int)(L % per);
        { const int q = per / 8, r = per % 8, xcd = wgid % 8, off = wgid / 8; wgid = (xcd < r ? xcd * (q + 1) : r * (q + 1) + (xcd - r) * q) + off; }
        const int nig = 8 * nN, gid = wgid / nig, fm = gid * 8, gsz = (nM - fm) < 8 ? (nM - fm) : 8;
        u.pm = fm + ((wgid % nig) % gsz); u.pn = (wgid % nig) / gsz;
        if (cmask) { unsigned m = cmask; for (int k = u.pn; k > 0; --k) m &= m - 1u; u.pn = __builtin_ctz(m); }
        return true;
    }
};
template <int LDA, int KK, bool PERM, class Epi, bool TRANSP = true>
DEV void gemm_stream(const bf16_t* __restrict__ A, size_t GA, const bf16_t* __restrict__ Bt, size_t GB, const Order S, const Epi& E, char* smem) {
    LAS unsigned char* lds = (LAS unsigned char*)smem;
    const int tid = lid(), wid = __builtin_amdgcn_readfirstlane(tid >> 6), lane = tid & 63, wr = wid >> 2, wc = wid & 3, fr = lane & 15, fq = lane >> 4;
    constexpr int nt = KK / BK;
    unsigned voffA[2], voffB[2];
#pragma unroll
    for (int i = 0; i < 2; ++i) { int R, C; stage_rc(tid * 16 + i * 8192, R, C); const int Rb = PERM ? ((R & ~31) + perm32(R & 31)) : R;
        voffA[i] = (unsigned)(R * LDA + C) * 2u; voffB[i] = (unsigned)(Rb * KK + C) * 2u; }
    constexpr size_t kstep = (size_t)(BK * 2), hstepA = (size_t)HALF * LDA * 2, hstepB = (size_t)HALF * KK * 2;
    const unsigned ldsw = (unsigned)wid * 1024u;
    const int aoff = lds_byte(wr * 64 + fr, fq * 8), boff = lds_byte(wc * 32 + fr, fq * 8);
    LAS unsigned char* ldsB = lds + 4 * HTB + boff;
#define G_SA(b, h) (((b) * 2 + (h)) * HTB)
#define G_SB(b, h) ((4 + (b) * 2 + (h)) * HTB)
#define G_STAGE(bufoff, soff, voff, RS) do { _Pragma("unroll") for (int _i = 0; _i < 2; ++_i) \
        __builtin_amdgcn_raw_ptr_buffer_load_lds(RS, (LAS void*)(lds + (bufoff) + ldsw + _i * 8192), 16, (int)(voff)[_i], (int)(soff), 0, 0); } while (0)
#define G_LDA(dst, b, h) do { _Pragma("unroll") for (int m = 0; m < 4; ++m) _Pragma("unroll") for (int k = 0; k < 2; ++k) dst[m][k] = *(const LAS bf16x8*)(lds + G_SA(b, h) + aoff + m * 2048 + k * 1024); } while (0)
#define G_LDB(dst, b, h) do { _Pragma("unroll") for (int n = 0; n < 2; ++n) _Pragma("unroll") for (int k = 0; k < 2; ++k) dst[n][k] = *(const LAS bf16x8*)(ldsB + (((b) * 2 + (h)) * HTB + n * 2048 + k * 1024)); } while (0)
#define G_MMA(ai, bj, At_, Bt_) do { __builtin_amdgcn_s_setprio(1); _Pragma("unroll") for (int m = 0; m < 4; ++m) _Pragma("unroll") for (int n = 0; n < 2; ++n) _Pragma("unroll") for (int k = 0; k < 2; ++k) \
        acc[ai][bj][m][n] = TRANSP ? __builtin_amdgcn_mfma_f32_16x16x32_bf16(Bt_[n][k], At_[m][k], acc[ai][bj][m][n], 0, 0, 0) : __builtin_amdgcn_mfma_f32_16x16x32_bf16(At_[m][k], Bt_[n][k], acc[ai][bj][m][n], 0, 0, 0); __builtin_amdgcn_s_setprio(0); } while (0)
#define G_WAIT_V(n) asm volatile("s_waitcnt vmcnt(" #n ")" ::: "memory")
#define G_WAIT_L(n) asm volatile("s_waitcnt lgkmcnt(" #n ")" ::: "memory")
#define G_BAR __builtin_amdgcn_s_barrier()
#define G_SCHED __builtin_amdgcn_sched_barrier(0)
#define G_ABASE(u) ((int)(((u).g * (int)GA + (u).pm * 256 * LDA) * 2))
#define G_BBASE(u) ((int)(((u).g * (int)GB + (u).pn * 256 * KK) * 2))
    const __amdgpu_buffer_rsrc_t rsA = __builtin_amdgcn_make_buffer_rsrc((void*)A, 0, -1, 0x00020000), rsB = __builtin_amdgcn_make_buffer_rsrc((void*)Bt, 0, -1, 0x00020000);
    Unit cur, nxt; int ui = 0;
    if (!S.next(0, cur)) return;
    if (S.stagger > 0 && ((S.c >> 3) & 1)) { for (int z = 0; z < S.stagger; ++z) __builtin_amdgcn_s_sleep(127); }
    f32x4 acc[2][2][4][2];
#pragma unroll
    for (int a_ = 0; a_ < 2; ++a_)
#pragma unroll
        for (int b_ = 0; b_ < 2; ++b_)
#pragma unroll
            for (int m = 0; m < 4; ++m)
#pragma unroll
                for (int n = 0; n < 2; ++n) acc[a_][b_][m][n] = (f32x4){0.f, 0.f, 0.f, 0.f};
    bf16x8 At[4][2], B0[2][2], B1[2][2];
    int cA = G_ABASE(cur), cB = G_BBASE(cur);
    __syncthreads();
    G_STAGE(G_SB(0, 0), cB, voffB, rsB); G_STAGE(G_SA(0, 0), cA, voffA, rsA); G_STAGE(G_SB(0, 1), cB + (int)hstepB, voffB, rsB); G_STAGE(G_SA(0, 1), cA + (int)hstepA, voffA, rsA);
    if (wr == 1) G_BAR;
    G_WAIT_V(4); G_BAR;
    G_STAGE(G_SB(1, 0), cB + (int)kstep, voffB, rsB); G_STAGE(G_SA(1, 0), cA + (int)kstep, voffA, rsA); G_STAGE(G_SB(1, 1), cB + (int)(hstepB + kstep), voffB, rsB);
    G_WAIT_V(6); G_BAR;
    for (;;) {
        const bool has_next = S.next(ui + 1, nxt);
        const int nA = has_next ? G_ABASE(nxt) : cA, nB = has_next ? G_BBASE(nxt) : cB;
        for (int t = 0; t < nt; t += 2) {
            const bool last = (t == nt - 2);
            const int a1 = cA + (t + 1) * (int)kstep;
            const int a2 = last ? nA : cA + (t + 2) * (int)kstep, b2 = last ? nB : cB + (t + 2) * (int)kstep;
            const int a3 = a2 + (int)kstep, b3 = b2 + (int)kstep;
            G_LDB(B0, 0, 0); G_SCHED; G_LDA(At, 0, 0); G_STAGE(G_SA(1, 1), a1 + (int)hstepA, voffA, rsA);
            G_WAIT_L(8); G_BAR; G_WAIT_L(0); G_MMA(0, 0, At, B0); G_BAR; G_SCHED;
            G_LDB(B1, 0, 1); G_STAGE(G_SB(0, 0), b2, voffB, rsB);
            G_BAR; G_WAIT_L(0); G_MMA(0, 1, At, B1); G_BAR;
            G_LDA(At, 0, 1); G_STAGE(G_SA(0, 0), a2, voffA, rsA);
            G_BAR; G_WAIT_L(0); G_MMA(1, 0, At, B0); G_BAR; G_SCHED;
            G_STAGE(G_SB(0, 1), b2 + (int)hstepB, voffB, rsB);
            G_WAIT_V(6); G_BAR; G_MMA(1, 1, At, B1); G_BAR;
            G_LDB(B0, 1, 0); G_SCHED; G_LDA(At, 1, 0); G_STAGE(G_SA(0, 1), a2 + (int)hstepA, voffA, rsA);
            G_WAIT_L(8); G_BAR; G_WAIT_L(0); G_MMA(0, 0, At, B0); G_BAR; G_SCHED;
            G_LDB(B1, 1, 1); G_STAGE(G_SB(1, 0), b3, voffB, rsB);
            G_BAR; G_WAIT_L(0); G_MMA(0, 1, At, B1); G_BAR;
            G_LDA(At, 1, 1); G_STAGE(G_SA(1, 0), a3, voffA, rsA);
            G_BAR; G_WAIT_L(0); G_MMA(1, 0, At, B0); G_BAR; G_SCHED;
            G_STAGE(G_SB(1, 1), b3 + (int)hstepB, voffB, rsB);
            G_WAIT_V(6); G_BAR; G_MMA(1, 1, At, B1); G_BAR;
        }
        { const int tz = lid();
          const int wz = tz >> 6, lz = tz & 63; E(acc, cur, wz >> 2, wz & 3, lz & 15, lz >> 4); }
        if (!has_next) break;
#pragma unroll
        for (int a_ = 0; a_ < 2; ++a_)
#pragma unroll
            for (int b_ = 0; b_ < 2; ++b_)
#pragma unroll
                for (int m = 0; m < 4; ++m)
#pragma unroll
                    for (int n = 0; n < 2; ++n) acc[a_][b_][m][n] = (f32x4){0.f, 0.f, 0.f, 0.f};
        cur = nxt; cA = nA; cB = nB; ++ui;
    }
    G_WAIT_V(0);
    if (wr == 0) G_BAR;
    G_BAR;
#undef G_SA
#undef G_SB
#undef G_STAGE
#undef G_LDA
#undef G_LDB
#undef G_MMA
#undef G_ABASE
#undef G_BBASE
}

typedef int v8i __attribute__((ext_vector_type(8)));
DEV int swz8(int r) { return ((r >> 1) & 1) | (((r >> 2) & 1) << 2); }
template <int KB, bool PERM, class Epi>
DEV void gemm_stream_f8(const unsigned char* __restrict__ A, const unsigned char* __restrict__ Bt, const Order S, const Epi& E, char* smem) {
    LAS unsigned char* lds = (LAS unsigned char*)smem;
    const int tid = lid(), wid = __builtin_amdgcn_readfirstlane(tid >> 6), lane = tid & 63, wr = wid >> 2, wc = wid & 3, fr = lane & 15, fq = lane >> 4;
    constexpr int nt = KB / 128;
    unsigned voff[2], voffB[2];
#pragma unroll
    for (int i = 0; i < 2; ++i) { const int q = tid + i * 512, R = q >> 3, sl = q & 7, pc = sl ^ swz8(R & 15); voff[i] = (unsigned)(R * KB + pc * 16);
        const int Rb = PERM ? ((R & ~31) + perm32(R & 31)) : R; voffB[i] = (unsigned)(Rb * KB + pc * 16); }
    constexpr size_t kstep = 128, hstep = (size_t)HALF * KB;
    const unsigned ldsw = (unsigned)wid * 1024u;
    const int sw = swz8(fr);
    const int aoff = (wr * 64 + fr) * 128 + (((2 * fq) ^ sw) << 4), boff = (wc * 32 + fr) * 128 + (((2 * fq) ^ sw) << 4);
    const int aoff2 = aoff ^ 16, boff2 = boff ^ 16;
    LAS unsigned char* ldsB1 = lds + 4 * HTB + boff; LAS unsigned char* ldsB2 = lds + 4 * HTB + boff2;
#define G_SA(b, h) (((b) * 2 + (h)) * HTB)
#define G_SB(b, h) ((4 + (b) * 2 + (h)) * HTB)
#define G_STAGE(bufoff, soff, RS) do { _Pragma("unroll") for (int _i = 0; _i < 2; ++_i) \
        __builtin_amdgcn_raw_ptr_buffer_load_lds(RS, (LAS void*)(lds + (bufoff) + ldsw + _i * 8192), 16, (int)((bufoff) >= 4 * HTB ? voffB[_i] : voff[_i]), (int)(soff), 0, 0); } while (0)
#define G_LD8(dst, base, base2) do { const u32x4 _a = *(const LAS u32x4*)(lds + (base)), _b = *(const LAS u32x4*)(lds + (base2)); \
        dst = (v8i){(int)_a.x, (int)_a.y, (int)_a.z, (int)_a.w, (int)_b.x, (int)_b.y, (int)_b.z, (int)_b.w}; } while (0)
#define G_LDA(dst, b, h) do { _Pragma("unroll") for (int m = 0; m < 4; ++m) G_LD8(dst[m], G_SA(b, h) + aoff + m * 2048, G_SA(b, h) + aoff2 + m * 2048); } while (0)
#define G_LDB(dst, b, h) do { _Pragma("unroll") for (int n = 0; n < 2; ++n) { const u32x4 _a = *(const LAS u32x4*)(ldsB1 + (((b) * 2 + (h)) * HTB + n * 2048)), _b = *(const LAS u32x4*)(ldsB2 + (((b) * 2 + (h)) * HTB + n * 2048)); \
        dst[n] = (v8i){(int)_a.x, (int)_a.y, (int)_a.z, (int)_a.w, (int)_b.x, (int)_b.y, (int)_b.z, (int)_b.w}; } } while (0)
#define G_MMA(ai, bj, At_, Bt_) do { __builtin_amdgcn_s_setprio(1); _Pragma("unroll") for (int m = 0; m < 4; ++m) _Pragma("unroll") for (int n = 0; n < 2; ++n) \
        acc[ai][bj][m][n] = __builtin_amdgcn_mfma_scale_f32_16x16x128_f8f6f4(Bt_[n], At_[m], acc[ai][bj][m][n], 0, 0, 0, 0x7F7F7F7F, 0, 0x7F7F7F7F); __builtin_amdgcn_s_setprio(0); } while (0)
#define G_ABASE(u) ((int)((u).pm * 256 * KB))
#define G_BBASE(u) ((int)((u).pn * 256 * KB))
    const __amdgpu_buffer_rsrc_t rsA = __builtin_amdgcn_make_buffer_rsrc((void*)A, 0, -1, 0x00020000), rsB = __builtin_amdgcn_make_buffer_rsrc((void*)Bt, 0, -1, 0x00020000);
    Unit cur, nxt; int ui = 0;
    if (!S.next(0, cur)) return;
    if (S.stagger > 0 && ((S.c >> 3) & 1)) { for (int z = 0; z < S.stagger; ++z) __builtin_amdgcn_s_sleep(127); }
    f32x4 acc[2][2][4][2];
#pragma unroll
    for (int a_ = 0; a_ < 2; ++a_)
#pragma unroll
        for (int b_ = 0; b_ < 2; ++b_)
#pragma unroll
            for (int m = 0; m < 4; ++m)
#pragma unroll
                for (int n = 0; n < 2; ++n) acc[a_][b_][m][n] = (f32x4){0.f, 0.f, 0.f, 0.f};
    v8i At[4], B0[2], B1[2];
    int cA = G_ABASE(cur), cB = G_BBASE(cur);
    __syncthreads();
    G_STAGE(G_SB(0, 0), cB, rsB); G_STAGE(G_SA(0, 0), cA, rsA); G_STAGE(G_SB(0, 1), cB + (int)hstep, rsB); G_STAGE(G_SA(0, 1), cA + (int)hstep, rsA);
    if (wr == 1) G_BAR;
    G_WAIT_V(4); G_BAR;
    G_STAGE(G_SB(1, 0), cB + (int)kstep, rsB); G_STAGE(G_SA(1, 0), cA + (int)kstep, rsA); G_STAGE(G_SB(1, 1), cB + (int)(hstep + kstep), rsB);
    G_WAIT_V(6); G_BAR;
    for (;;) {
        const bool has_next = S.next(ui + 1, nxt);
        const int nA = has_next ? G_ABASE(nxt) : cA, nB = has_next ? G_BBASE(nxt) : cB;
        for (int t = 0; t < nt; t += 2) {
            const bool last = (t == nt - 2);
            const int a1 = cA + (t + 1) * (int)kstep;
            const int a2 = last ? nA : cA + (t + 2) * (int)kstep, b2 = last ? nB : cB + (t + 2) * (int)kstep;
            const int a3 = a2 + (int)kstep, b3 = b2 + (int)kstep;
            G_LDB(B0, 0, 0); G_SCHED; G_LDA(At, 0, 0); G_STAGE(G_SA(1, 1), a1 + (int)hstep, rsA);
            G_WAIT_L(8); G_BAR; G_WAIT_L(0); G_MMA(0, 0, At, B0); G_BAR; G_SCHED;
            G_LDB(B1, 0, 1); G_STAGE(G_SB(0, 0), b2, rsB);
            G_BAR; G_WAIT_L(0); G_MMA(0, 1, At, B1); G_BAR;
            G_LDA(At, 0, 1); G_STAGE(G_SA(0, 0), a2, rsA);
            G_BAR; G_WAIT_L(0); G_MMA(1, 0, At, B0); G_BAR; G_SCHED;
            G_STAGE(G_SB(0, 1), b2 + (int)hstep, rsB);
            G_WAIT_V(6); G_BAR; G_MMA(1, 1, At, B1); G_BAR;
            G_LDB(B0, 1, 0); G_SCHED; G_LDA(At, 1, 0); G_STAGE(G_SA(0, 1), a2 + (int)hstep, rsA);
            G_WAIT_L(8); G_BAR; G_WAIT_L(0); G_MMA(0, 0, At, B0); G_BAR; G_SCHED;
            G_LDB(B1, 1, 1); G_STAGE(G_SB(1, 0), b3, rsB);
            G_BAR; G_WAIT_L(0); G_MMA(0, 1, At, B1); G_BAR;
            G_LDA(At, 1, 1); G_STAGE(G_SA(1, 0), a3, rsA);
            G_BAR; G_WAIT_L(0); G_MMA(1, 0, At, B0); G_BAR; G_SCHED;
            G_STAGE(G_SB(1, 1), b3 + (int)hstep, rsB);
            G_WAIT_V(6); G_BAR; G_MMA(1, 1, At, B1); G_BAR;
        }
        { const int tz = lid();
          const int wz = tz >> 6, lz = tz & 63; E(acc, cur, wz >> 2, wz & 3, lz & 15, lz >> 4); }
        if (!has_next) break;
#pragma unroll
        for (int a_ = 0; a_ < 2; ++a_)
#pragma unroll
            for (int b_ = 0; b_ < 2; ++b_)
#pragma unroll
                for (int m = 0; m < 4; ++m)
#pragma unroll
                    for (int n = 0; n < 2; ++n) acc[a_][b_][m][n] = (f32x4){0.f, 0.f, 0.f, 0.f};
        cur = nxt; cA = nA; cB = nB; ++ui;
    }
    G_WAIT_V(0);
    if (wr == 0) G_BAR;
    G_BAR;
#undef G_SA
#undef G_SB
#undef G_STAGE
#undef G_LD8
#undef G_LDA
#undef G_LDB
#undef G_MMA
#undef G_ABASE
#undef G_BBASE
}

struct EpiBf16 {
    bf16_t* C; long ldc; long gc; bool commit = true; float asc = 1.f;
    DEV void operator()(const f32x4 (&acc)[2][2][4][2], const Unit& u, int wr, int wc, int fr, int fq) const {
        if (!commit && acc[0][0][0][0][0] != 1.2345e30f) return;
        const char* ub = (const char*)(C + (size_t)u.g * gc + (size_t)(u.pm * 256) * ldc + u.pn * 256);
        const unsigned lo = (unsigned)((wr * 64 + fr) * (int)ldc + wc * 32 + fq * 8) * 2u;
#pragma unroll
        for (int ai = 0; ai < 2; ++ai)
#pragma unroll
            for (int m = 0; m < 4; ++m) {
#pragma unroll
                for (int bj = 0; bj < 2; ++bj) {
                    const f32x4 v0 = acc[ai][bj][m][0] * asc, v1 = acc[ai][bj][m][1] * asc; u32x4 w; w.x = cvtpk_v(v0[0], v0[1]); w.y = cvtpk_v(v0[2], v0[3]); w.z = cvtpk_v(v1[0], v1[1]); w.w = cvtpk_v(v1[2], v1[3]);
                    *(u32x4*)(ub + (lo + (unsigned)(((ai * 128 + m * 16) * (int)ldc + bj * 128) * 2))) = w;
                }
            }
    }
};
template <bool INBF> struct EpiResidB {
    const float *xin_l, *xin_c; bf16_t* xb; const float* gate;
    DEV void operator()(const f32x4 (&acc)[2][2][4][2], const Unit& u, int wr, int wc, int fr, int fq) const {
        const int brow = u.pm * 256, bcol = u.pn * 256;
        const bool isc = brow >= TL; const int r = isc ? 8 : (brow >> 11);
        const float* g = gate + (long)r * 12288 + bcol + wc * 32 + fq * 8;
        f32x4 gv[2][2];
#pragma unroll
        for (int bj = 0; bj < 2; ++bj) { gv[bj][0] = *(const f32x4*)(g + bj * 128); gv[bj][1] = *(const f32x4*)(g + bj * 128 + 4); }
        const size_t e0 = ((size_t)brow + wr * 64 + fr) * DM + bcol + wc * 32 + fq * 8;
        const char* xi = (const char*)((isc ? xin_c - (size_t)TL * DM : xin_l) + e0); char* xo = (char*)(xb + e0);
#pragma unroll
        for (int ai = 0; ai < 2; ++ai)
#pragma unroll
            for (int mp = 0; mp < 2; ++mp) {
                f32x4 xv[2][2][2];
#pragma unroll
                for (int mm = 0; mm < 2; ++mm)
#pragma unroll
                    for (int bj = 0; bj < 2; ++bj) { const unsigned eo = (unsigned)((ai * 128 + (mp * 2 + mm) * 16) * DM + bj * 128);
                        if constexpr (INBF) { const u32x4 w = *(const u32x4*)(xo + eo * 2u); xv[mm][bj][0] = (f32x4){bflo(w.x), bfhi(w.x), bflo(w.y), bfhi(w.y)}; xv[mm][bj][1] = (f32x4){bflo(w.z), bfhi(w.z), bflo(w.w), bfhi(w.w)}; }
                        else { xv[mm][bj][0] = *(const f32x4*)(xi + eo * 4u); xv[mm][bj][1] = *(const f32x4*)(xi + eo * 4u + 16u); } }
#pragma unroll
                for (int mm = 0; mm < 2; ++mm)
#pragma unroll
                    for (int bj = 0; bj < 2; ++bj) { const unsigned eo = (unsigned)((ai * 128 + (mp * 2 + mm) * 16) * DM + bj * 128);
                        const f32x4 y0 = xv[mm][bj][0] + gv[bj][0] * acc[ai][bj][mp * 2 + mm][0], y1 = xv[mm][bj][1] + gv[bj][1] * acc[ai][bj][mp * 2 + mm][1];
                        u32x4 w; w.x = cvtpk_v(y0[0], y0[1]); w.y = cvtpk_v(y0[2], y0[3]); w.z = cvtpk_v(y1[0], y1[1]); w.w = cvtpk_v(y1[2], y1[3]);
                        *(u32x4*)(xo + eo * 2u) = w; }
            }
    }
};
struct EpiScoresT {
    float* SC;
    DEV void operator()(const f32x4 (&acc)[2][2][4][2], const Unit& u, int wr, int wc, int fr, int fq) const {
#pragma unroll
        for (int bj = 0; bj < 2; ++bj)
#pragma unroll
            for (int n = 0; n < 2; ++n) {
                float* cp = SC + ((size_t)(u.pn * (TA / 64) + u.pm * 4 + wr) * 256 + bj * 128 + wc * 32 + n * 16 + fr) * 64 + fq * 4;
#pragma unroll
                for (int ai = 0; ai < 2; ++ai)
#pragma unroll
                    for (int m = 0; m < 4; ++m) *(f32x4*)(cp + ai * (2 * 256 * 64) + m * 16) = acc[ai][bj][m][n];
            }
    }
};
struct EpiMerge {
    bf16_t* M; const bf16_t* Z; const float* bg; float asc;
    DEV void operator()(const f32x4 (&acc)[2][2][4][2], const Unit& u, int wr, int wc, int fr, int fq) const {
        const int j0 = u.pn * 64 + wc * 16 + fq * 4;
        f32x4 bv[4];
#pragma unroll
        for (int nb = 0; nb < 4; ++nb) bv[nb] = *(const f32x4*)(bg + nb * 2048 + j0);
        const char* zb = (const char*)(Z + ((size_t)u.pm * 256 + wr * 64 + fr) * 8192 + j0); char* mb = (char*)(M + ((size_t)u.pm * 256 + wr * 64 + fr) * 2048 + j0);
        u32x2 zwn[4][4];
#pragma unroll
        for (int m = 0; m < 4; ++m)
#pragma unroll
            for (int nb = 0; nb < 4; ++nb) zwn[m][nb] = *(const u32x2*)(zb + (unsigned)(((m * 16) * 8192 + nb * 2048) * 2));
#pragma unroll
        for (int ai = 0; ai < 2; ++ai) {
            u32x2 zw[4][4];
#pragma unroll
            for (int m = 0; m < 4; ++m)
#pragma unroll
                for (int nb = 0; nb < 4; ++nb) { zw[m][nb] = zwn[m][nb]; if (ai == 0) zwn[m][nb] = *(const u32x2*)(zb + (unsigned)(((128 + m * 16) * 8192 + nb * 2048) * 2)); }
#pragma unroll
            for (int m = 0; m < 4; ++m) {
                f32x4 s = {0.f, 0.f, 0.f, 0.f};
#pragma unroll
                for (int nb = 0; nb < 4; ++nb) {
                    const f32x4 a = acc[ai][nb >> 1][m][nb & 1] * asc + bv[nb];
                    s[0] += sigmoidf_(a[0]) * bflo(zw[m][nb].x); s[1] += sigmoidf_(a[1]) * bfhi(zw[m][nb].x);
                    s[2] += sigmoidf_(a[2]) * bflo(zw[m][nb].y); s[3] += sigmoidf_(a[3]) * bfhi(zw[m][nb].y);
                }
                u32x2 w; w.x = cvtpk(s[0], s[1]); w.y = cvtpk(s[2], s[3]);
                *(u32x2*)(mb + (unsigned)((ai * 128 + m * 16) * 2048 * 2)) = w;
            }
        }
    }
};
struct EpiResid {
    const float *xin_l, *xin_c; float *xout_l, *xout_c; const float* gate;
    DEV void operator()(const f32x4 (&acc)[2][2][4][2], const Unit& u, int wr, int wc, int fr, int fq) const {
        const int brow = u.pm * 256, bcol = u.pn * 256;
        const bool isc = brow >= TL; const int r = isc ? 8 : (brow >> 11);
        const float* xi = isc ? xin_c - (long)TL * DM : xin_l; float* xo = isc ? xout_c - (long)TL * DM : xout_l;
        const float* g = gate + (long)r * 12288;
        f32x4 gv[2][2];
#pragma unroll
        for (int bj = 0; bj < 2; ++bj)
#pragma unroll
            for (int n = 0; n < 2; ++n) gv[bj][n] = *(const f32x4*)(g + bcol + bj * 128 + wc * 32 + n * 16 + fq * 4);
        const char* xib = (const char*)(xi + ((long)brow + wr * 64 + fr) * DM + bcol + wc * 32 + fq * 4); char* xob = (char*)(xo + ((long)brow + wr * 64 + fr) * DM + bcol + wc * 32 + fq * 4);
#pragma unroll
        for (int ai = 0; ai < 2; ++ai)
#pragma unroll
            for (int mp = 0; mp < 2; ++mp) {
                f32x4 xv[2][2][2];
#pragma unroll
                for (int mm = 0; mm < 2; ++mm)
#pragma unroll
                    for (int bj = 0; bj < 2; ++bj)
#pragma unroll
                        for (int n = 0; n < 2; ++n) xv[mm][bj][n] = *(const f32x4*)(xib + (unsigned)((((ai * 128 + (mp * 2 + mm) * 16) * DM) + bj * 128 + n * 16) * 4));
#pragma unroll
                for (int mm = 0; mm < 2; ++mm)
#pragma unroll
                    for (int bj = 0; bj < 2; ++bj)
#pragma unroll
                        for (int n = 0; n < 2; ++n)
                            *(f32x4*)(xob + (unsigned)((((ai * 128 + (mp * 2 + mm) * 16) * DM) + bj * 128 + n * 16) * 4)) = xv[mm][bj][n] + gv[bj][n] * acc[ai][bj][mp * 2 + mm][n];
            }
    }
};
}

DEV void cvt_tile_T(const float* __restrict__ src, long ld_src, int k0, int n0, bf16_t* __restrict__ dst, long ldd, long drow0  , int gperm  , float* tl) {
    const int tid = lid();
    {   const int kr = tid >> 4, nc = (tid & 15) * 4;
        f32x4 v[8];
#pragma unroll
        for (int h = 0; h < 8; ++h) v[h] = *(const f32x4*)(src + (long)(k0 + kr + 32 * h) * ld_src + n0 + nc);
#pragma unroll
        for (int h = 0; h < 8; ++h) { float* t = tl + (kr + 32 * h) * 65 + nc; t[0] = v[h][0]; t[1] = v[h][1]; t[2] = v[h][2]; t[3] = v[h][3]; }
    }
    __syncthreads();
    {   const int nr = tid >> 3, kc = (tid & 7) * 8;
        long drow;
        if (gperm < 0) drow = drow0 + nr;
        else drow = drow0 + (gperm >> 1) * 128 + (nr >> 4) * 32 + (gperm & 1) * 16 + (nr & 15);
#pragma unroll
        for (int j4 = 0; j4 < 4; ++j4) {
            float v[8];
#pragma unroll
            for (int j = 0; j < 8; ++j) v[j] = tl[(j4 * 64 + kc + j) * 65 + nr];
            if (gperm == -1) {
                u32x4 w; w.x = cvtpk(v[0], v[1]); w.y = cvtpk(v[2], v[3]); w.z = cvtpk(v[4], v[5]); w.w = cvtpk(v[6], v[7]);
                *(u32x4*)(dst + drow * ldd + k0 + j4 * 64 + kc) = w;
            } else {
#pragma unroll
                for (int j = 0; j < 8; ++j) v[j] = fminf(fmaxf(v[j] * 256.f, -448.f), 448.f);
                int d0 = 0, d1 = 0;
                d0 = __builtin_amdgcn_cvt_pk_fp8_f32(v[0], v[1], d0, false); d0 = __builtin_amdgcn_cvt_pk_fp8_f32(v[2], v[3], d0, true);
                d1 = __builtin_amdgcn_cvt_pk_fp8_f32(v[4], v[5], d1, false); d1 = __builtin_amdgcn_cvt_pk_fp8_f32(v[6], v[7], d1, true);
                u32x2 w; w.x = (unsigned)d0; w.y = (unsigned)d1;
                *(u32x2*)((unsigned char*)dst + drow * ldd + k0 + j4 * 64 + kc) = w;
            }
        }
    }
    __syncthreads();
}
DEV void cvt_matrix_T(const float* src, int K, int N, bf16_t* dst, float* tl, int bid, int nb, int& cursor, int mode = -1) {
    const int tk = K / 256, tn = N / 64, nt = tk * tn;
    int first = ((bid - cursor) % nb + nb) % nb;
    for (int u = first; u < nt; u += nb) { const int ik = u % tk, in_ = u / tk; cvt_tile_T(src, N, ik * 256, in_ * 64, dst, K, (long)in_ * 64, mode, tl); }
    cursor = (cursor + nt) % nb;
}
DEV void cvt_straight(const float* __restrict__ src, bf16_t* __restrict__ dst, long n8, int bid, int nb) {
    const int tix = lid();
    for (long i = (long)bid * 512 + tix; i < n8; i += (long)nb * 512) {
        const f32x4 a = *(const f32x4*)(src + i * 8), b = *(const f32x4*)(src + i * 8 + 4);
        u32x4 w; w.x = cvtpk(a[0], a[1]); w.y = cvtpk(a[2], a[3]); w.z = cvtpk(b[0], b[1]); w.w = cvtpk(b[2], b[3]);
        *(u32x4*)(dst + i * 8) = w;
    }
}

DEV unsigned pack_i8x4(float a, float b, float c, float d) {
    const unsigned m0 = __float_as_uint(a + 12582912.f), m1 = __float_as_uint(b + 12582912.f), m2 = __float_as_uint(c + 12582912.f), m3 = __float_as_uint(d + 12582912.f);
    return __builtin_amdgcn_perm(m1, m0, 0x0c0c0400u) | __builtin_amdgcn_perm(m3, m2, 0x04000c0cu);
}
DEV void cvt_rows_ld(const float* __restrict__ src, int row0, int lane, f32x4 (&v)[2][8]) {
#pragma unroll
    for (int rr = 0; rr < 2; ++rr) { const float* sr = src + (size_t)(row0 + rr) * DM + lane * 16;
#pragma unroll
        for (int c = 0; c < 2; ++c)
#pragma unroll
            for (int k = 0; k < 4; ++k) v[rr][c * 4 + k] = *(const f32x4*)(sr + c * 1024 + k * 4); }
}
DEV void cvt_expert_tables(const P& p, int bid, int nb) {
    const int tix = lid(); const int wid = tix >> 6, lane = tix & 63;
    const int per = (8192 + nb * 8 - 1) / (nb * 8), nit = 4 * per;
    f32x4 v[2][8], vn[2][8];
    int it = 0, rp = bid * 8 + wid;
    while (it < nit && rp >= 8192) { ++it; rp = (bid * 8 + wid) + (it % per) * nb * 8; }
    if (it < nit) { const int tb = it / per; cvt_rows_ld((tb & 1 ? p.peer_v : p.peer_u) + (size_t)(tb >> 1) * 16384 * DM, rp * 2, lane, v); }
#pragma unroll 1
    while (it < nit) {
        int itn = it + 1, rpn = (bid * 8 + wid) + (itn % per) * nb * 8;
        while (itn < nit && rpn >= 8192) { ++itn; rpn = (bid * 8 + wid) + (itn % per) * nb * 8; }
        if (itn < nit) { const int tbn = itn / per; cvt_rows_ld((tbn & 1 ? p.peer_v : p.peer_u) + (size_t)(tbn >> 1) * 16384 * DM, rpn * 2, lane, vn); }
        const int tb = it / per, l = tb >> 1; const bool i8 = !(tb & 1); const int row0 = rp * 2;
        unsigned char* dst = (unsigned char*)wl(p, l, i8 ? W_U : W_V); float* descale = (float*)wl(p, l, i8 ? W_US : W_VS);
#pragma unroll
        for (int rr = 0; rr < 2; ++rr) {
            float am = 0.f;
#pragma unroll
            for (int q = 0; q < 8; ++q) am = fmaxf(am, fmaxf(fmaxf(fabsf(v[rr][q][0]), fabsf(v[rr][q][1])), fmaxf(fabsf(v[rr][q][2]), fabsf(v[rr][q][3]))));
            am = fmaxf(am, xshf<1>(am)); am = fmaxf(am, xshf<2>(am)); am = fmaxf(am, xshf<4>(am)); am = fmaxf(am, xshf<8>(am)); am = fmaxf(am, xshf<16>(am)); am = fmaxf(am, xshf<32>(am));
            const float top = i8 ? 127.f : 6.f;
            const float sc = am > 0.f ? top / am : 1.f;
#pragma unroll
            for (int c = 0; c < 2; ++c) {
                if (i8) { u32x4 w;
#pragma unroll
                    for (int k = 0; k < 4; ++k) { const f32x4 a = v[rr][c * 4 + k] * sc; w[k] = pack_i8x4(a[0], a[1], a[2], a[3]); }
                    *(u32x4*)(dst + (size_t)(c * 8 + (lane >> 3)) * (16384 * 128) + (size_t)(row0 + rr) * 128 + (lane & 7) * 16) = w;
                } else { u32x2 w = {0u, 0u};
                    { const f32x4 a0 = v[rr][c * 4] * sc, a1 = v[rr][c * 4 + 1] * sc, a2 = v[rr][c * 4 + 2] * sc, a3 = v[rr][c * 4 + 3] * sc;
                      w.x = __builtin_amdgcn_cvt_scalef32_pk_fp4_f32(w.x, a0[0], a0[1], 1.0f, 0); w.x = __builtin_amdgcn_cvt_scalef32_pk_fp4_f32(w.x, a0[2], a0[3], 1.0f, 1);
                      w.x = __builtin_amdgcn_cvt_scalef32_pk_fp4_f32(w.x, a1[0], a1[1], 1.0f, 2); w.x = __builtin_amdgcn_cvt_scalef32_pk_fp4_f32(w.x, a1[2], a1[3], 1.0f, 3);
                      w.y = __builtin_amdgcn_cvt_scalef32_pk_fp4_f32(w.y, a2[0], a2[1], 1.0f, 0); w.y = __builtin_amdgcn_cvt_scalef32_pk_fp4_f32(w.y, a2[2], a2[3], 1.0f, 1);
                      w.y = __builtin_amdgcn_cvt_scalef32_pk_fp4_f32(w.y, a3[0], a3[1], 1.0f, 2); w.y = __builtin_amdgcn_cvt_scalef32_pk_fp4_f32(w.y, a3[2], a3[3], 1.0f, 3); }
                    *(u32x2*)(dst + (size_t)(c * 4 + (lane >> 4)) * (16384 * 128) + (size_t)(row0 + rr) * 128 + (lane & 15) * 8) = w; }
            }
            if (lane == 0) descale[row0 + rr] = am > 0.f ? am / top : 1.f;
        }
#pragma unroll
        for (int rr = 0; rr < 2; ++rr)
#pragma unroll
            for (int q = 0; q < 8; ++q) v[rr][q] = vn[rr][q];
        it = itn; rp = rpn;
    }
}
DEV bf16x8 ld8f(const float* p_) { const f32x4 a = *(const f32x4*)p_, b = *(const f32x4*)(p_ + 4); u32x4 w = {cvtpk(a[0], a[1]), cvtpk(a[2], a[3]), cvtpk(b[0], b[1]), cvtpk(b[2], b[3])}; return *reinterpret_cast<bf16x8*>(&w); }
DEV void fold_subkeys(const float* __restrict__ sk, const float* __restrict__ wq, bf16_t* __restrict__ out, int bid, int nb) {
    const int tix = lid(); const int wid = tix >> 6, lane = tix & 63, r32 = lane & 31, hi = lane >> 5;
    for (int task = bid * 8 + wid; task < 16 * 64; task += nb * 8) {
        const int hs = task >> 6, ib = task & 63;
        bf16x8 bw[8];
#pragma unroll
        for (int ks = 0; ks < 8; ++ks) bw[ks] = ld8f(wq + (size_t)(ib * 32 + r32) * DM + hs * 128 + ks * 16 + hi * 8);
#pragma unroll
        for (int kb = 0; kb < 4; ++kb) {
            f32x16 acc = {};
#pragma unroll
            for (int ks = 0; ks < 8; ++ks) acc = __builtin_amdgcn_mfma_f32_32x32x16_bf16(ld8f(sk + (size_t)(hs * 128 + kb * 32 + r32) * 128 + ks * 16 + hi * 8), bw[ks], acc, 0, 0, 0);
#pragma unroll
            for (int rr = 0; rr < 16; ++rr) out[(size_t)(hs * 128 + kb * 32 + at_crow(rr, hi)) * DM + ib * 32 + r32] = (bf16_t)(cvtpk_v(acc[rr], acc[rr]) & 0xffffu);
        }
    }
}
struct TileD { const float* src; int ld_src, k0, n0; bf16_t* dst; int ldd, drow0, mode; };
constexpr int T_IN = 8 * 93, T_G = 4 * 8 * 32, T_B = 4 * 2 * 32, T_O = 8 * 32, T_UQ = 2 * 12, T_UKV = 1 * 16, T_INB = PROJ_BF16_TILES ? T_IN : 0;
constexpr int T_LAYER = T_IN + T_G + T_B + T_O + T_UQ + T_UKV + T_INB;
DEV TileD tile_desc(const P& p, int g) {
    const int l = g / T_LAYER; int r = g % T_LAYER; TileD d;
    if (r < T_IN) { d.src = p.w_in + (size_t)l * DM * INW; d.ld_src = INW; d.k0 = (r % 8) * 256; d.n0 = (r / 8) * 64; d.dst = wl(p, l, W_IN8); d.ldd = DM; d.drow0 = (r / 8) * 64; d.mode = -3; return d; }
    r -= T_IN;
    if (r < T_G) { const int gg = r >> 8, q = r & 255; d.src = p.w_gate + ((size_t)l * 4 + gg) * DM * DM; d.ld_src = DM; d.k0 = (q & 7) * 256; d.n0 = (q >> 3) * 64; d.dst = wl(p, l, W_G); d.ldd = DM; d.drow0 = (q >> 3) * 256; d.mode = gg; return d; }
    r -= T_G;
    if (r < T_B) { const int gg = r >> 6, q = r & 63; d.src = p.w_branch + ((size_t)l * 4 + gg) * 512 * DM; d.ld_src = DM; d.k0 = (q & 1) * 256; d.n0 = (q >> 1) * 64; d.dst = wl(p, l, W_B) + (size_t)gg * DM * 512; d.ldd = 512; d.drow0 = (q >> 1) * 64; d.mode = -1; return d; }
    r -= T_B;
    if (r < T_O) { d.src = p.w_o + (size_t)l * DM * DM; d.ld_src = DM; d.k0 = (r & 7) * 256; d.n0 = (r >> 3) * 64; d.dst = wl(p, l, W_O); d.ldd = DM; d.drow0 = (r >> 3) * 64; d.mode = -1; return d; }
    r -= T_O;
    if (r < T_UQ) { d.src = p.w_uq + (size_t)l * 512 * 768; d.ld_src = 768; d.k0 = (r & 1) * 256; d.n0 = (r >> 1) * 64; d.dst = wl(p, l, W_UQ); d.ldd = 512; d.drow0 = (r >> 1) * 64; d.mode = -1; return d; }
    r -= T_UQ;
    if (r < T_UKV) { d.src = p.w_ukv + (size_t)l * 256 * 1024; d.ld_src = 1024; d.k0 = 0; d.n0 = r * 64; d.dst = wl(p, l, W_UKV); d.ldd = 256; d.drow0 = r * 64; d.mode = -1; return d; }
    r -= T_UKV;
    d.src = p.w_in + (size_t)l * DM * INW; d.ld_src = INW; d.k0 = (r % 8) * 256; d.n0 = (r / 8) * 64; d.dst = wl(p, l, W_IN); d.ldd = DM; d.drow0 = (r / 8) * 64; d.mode = -1; return d;
}
DEV void phase_prologue(const P& p, char* smem, int bid, int nb) {
    const int tix = lid();
    float* tl = (float*)smem;
    {
        const int kr = tix >> 4, nc = (tix & 15) * 4, nr = tix >> 3, kc = (tix & 7) * 8;
        int g = bid; f32x4 v[8]; TileD d;
        if (g < 2 * T_LAYER) { d = tile_desc(p, g);
#pragma unroll
            for (int h = 0; h < 8; ++h) v[h] = *(const f32x4*)(d.src + (size_t)(d.k0 + kr + 32 * h) * d.ld_src + d.n0 + nc); }
#pragma unroll 1
        while (g < 2 * T_LAYER) {
#pragma unroll
            for (int h = 0; h < 8; ++h) { float* t = tl + (kr + 32 * h) * 65 + nc; t[0] = v[h][0]; t[1] = v[h][1]; t[2] = v[h][2]; t[3] = v[h][3]; }
            __syncthreads();
            const int gn = g + nb; TileD dn = d;
            if (gn < 2 * T_LAYER) { dn = tile_desc(p, gn);
#pragma unroll
                for (int h = 0; h < 8; ++h) v[h] = *(const f32x4*)(dn.src + (size_t)(dn.k0 + kr + 32 * h) * dn.ld_src + dn.n0 + nc); }
            long drow;
            if (d.mode == -3) { const int n_ = d.drow0 + nr, c = n_ & 31; drow = (n_ & ~31) + 16 * ((c >> 2) & 1) + 4 * (c >> 3) + (c & 3); }
            else if (d.mode < 0) drow = d.drow0 + nr;
            else drow = d.drow0 + (d.mode >> 1) * 128 + (nr >> 4) * 32 + (d.mode & 1) * 16 + (nr & 15);
#pragma unroll
            for (int j4 = 0; j4 < 4; ++j4) {
                float w8[8];
#pragma unroll
                for (int j = 0; j < 8; ++j) w8[j] = tl[(j4 * 64 + kc + j) * 65 + nr];
                if (d.mode == -1) {
                    u32x4 w; w.x = cvtpk(w8[0], w8[1]); w.y = cvtpk(w8[2], w8[3]); w.z = cvtpk(w8[4], w8[5]); w.w = cvtpk(w8[6], w8[7]);
                    *(u32x4*)(d.dst + drow * d.ldd + d.k0 + j4 * 64 + kc) = w;
                } else {
#pragma unroll
                    for (int j = 0; j < 8; ++j) w8[j] = fminf(fmaxf(w8[j] * 256.f, -448.f), 448.f);
                    int d0 = 0, d1 = 0;
                    d0 = __builtin_amdgcn_cvt_pk_fp8_f32(w8[0], w8[1], d0, false); d0 = __builtin_amdgcn_cvt_pk_fp8_f32(w8[2], w8[3], d0, true);
                    d1 = __builtin_amdgcn_cvt_pk_fp8_f32(w8[4], w8[5], d1, false); d1 = __builtin_amdgcn_cvt_pk_fp8_f32(w8[6], w8[7], d1, true);
                    u32x2 w; w.x = (unsigned)d0; w.y = (unsigned)d1;
                    *(u32x2*)((unsigned char*)d.dst + drow * d.ldd + d.k0 + j4 * 64 + kc) = w;
                }
            }
            __syncthreads();
            g = gn; d = dn;
        }
    }
    for (int l = 0; l < 2; ++l) {
        { unsigned char* d = (unsigned char*)wl(p, l, W_IN8) + (size_t)INW * DM; const long n16 = (long)(INP - INW) * DM / 16;
          for (long i = (long)bid * 512 + tix; i < n16; i += (long)nb * 512) *(u32x4*)(d + i * 16) = (u32x4){0u, 0u, 0u, 0u}; }
        if (PROJ_BF16_TILES) { bf16_t* d = wl(p, l, W_IN) + (size_t)INW * DM; const long n8 = (long)(INP - INW) * DM / 8;
          for (long i = (long)bid * 512 + tix; i < n8; i += (long)nb * 512) *(u32x4*)(d + i * 8) = (u32x4){0u, 0u, 0u, 0u}; }
        fold_subkeys(p.peer_sub_keys + (size_t)l * 262144, p.peer_w_query + (size_t)l * DM * DM, wl(p, l, W_Q), bid, nb);
    }
    cvt_expert_tables(p, bid, nb);
    {
        float* sl = (float*)smem;
        float* red = sl + 9 * 2048;
        const int wid = tix >> 6, lane = tix & 63;
        __syncthreads();
        for (int e = tix; e < 9 * 2048; e += 512) { const int r = e >> 11, i = e & 2047; sl[e] = siluf_(r < 8 ? p.c[r * DM + i] : p.c_ctx[i]); }
        __syncthreads();
        for (int u = bid; u < 256; u += nb) {
            const int l = u >> 7, j = (u & 127) * 96 + lane * 2; const bool act = lane < 48;
            const float* w = p.w_mod + (size_t)l * DM * 12288 + j;
            f32x2 a[9];
#pragma unroll
            for (int r = 0; r < 9; ++r) a[r] = (f32x2){0.f, 0.f};
#pragma unroll 1
            for (int i0 = wid * 256; i0 < wid * 256 + 256; i0 += 32) {
                f32x2 wv[32];
#pragma unroll
                for (int q = 0; q < 32; ++q) wv[q] = act ? *(const f32x2*)(w + (size_t)(i0 + q) * 12288) : (f32x2){0.f, 0.f};
#pragma unroll
                for (int q4 = 0; q4 < 8; ++q4) {
#pragma unroll
                    for (int r = 0; r < 9; ++r) { const f32x4 sv = *(const f32x4*)(sl + r * 2048 + i0 + q4 * 4);
#pragma unroll
                        for (int e = 0; e < 4; ++e) { a[r][0] += sv[e] * wv[q4 * 4 + e][0]; a[r][1] += sv[e] * wv[q4 * 4 + e][1]; } }
                }
            }
            __syncthreads();
            if (act) {
#pragma unroll
                for (int r = 0; r < 9; ++r) { red[(wid * 9 + r) * 96 + lane * 2] = a[r][0]; red[(wid * 9 + r) * 96 + lane * 2 + 1] = a[r][1]; } }
            __syncthreads();
            for (int e = tix; e < 9 * 96; e += 512) {
                const int r = e / 96, jj = e % 96; float sacc = 0.f;
#pragma unroll
                for (int w8 = 0; w8 < 8; ++w8) sacc += red[(w8 * 9 + r) * 96 + jj];
                const int jg = (u & 127) * 96 + jj;
                wsf(p, OFF_MOD)[((size_t)l * 9 + r) * 12288 + jg] = sacc + p.b_mod[(size_t)l * 12288 + jg];
            }
        }
    }
    if (bid == 0) {
        float* ra = wsf(p, OFF_ROPEA); float* rr = wsf(p, OFF_ROPER); float* misc = wsf(p, OFF_MISC);
        for (int e = tix; e < 64 * 16; e += 512) { const int pos = e >> 4, i = e & 15; const float inv = exp2f(-(float)i / 16.f * 13.287712379549449f);
            float s, c; sincosf((float)pos * inv, &s, &c); ra[e] = c; ra[1024 + e] = s; }
        for (int e = tix; e < 64 * 32; e += 512) { const int pos = e >> 5, i = e & 31; const float inv = exp2f(-(float)i / 32.f * 13.287712379549449f);
            float s, c; sincosf((float)pos * inv, &s, &c); rr[e] = c; rr[2048 + e] = s; }
        if (tix < 128) {
            const int l = tix >> 6, i = tix & 63; const float* dl = p.diff_lambda + l * 256;
            const float s01 = wave_sum(dl[i] * dl[64 + i]), s23 = wave_sum(dl[128 + i] * dl[192 + i]);
            const float lam_init = 0.8f - 0.6f * expf(-0.3f * (float)l);
            if (i == 0) { misc[l * 2] = expf(s01) - expf(s23) + lam_init; misc[l * 2 + 1] = lam_init; }
        }
        if (tix < 16) {
            const float x = p.ret_decay[tix]; misc[8 + tix] = -log1pf(expf(-x)) * 1.4426950408889634f;
        }
    }
}

DEV void phase_norm(const float* xl, const float* xc, const float* g, const float* mod  , int shi, int sci, bf16_t* H, int nrows, int bid, int nb, unsigned char* H8 = nullptr, unsigned char* HI8 = nullptr, float* HSC = nullptr, const bf16_t* xb = nullptr  ) {
    const int tix = lid(); const int wid = tix >> 6, lane = tix & 63;
    for (int row = bid * 8 + wid; row < nrows; row += nb * 8) {
        const float* src = row < TL ? xl + (size_t)row * DM : xc + (size_t)(row - TL) * DM;
        const int r = row < TL ? (row >> 11) : 8;
        const float* sh = mod + (size_t)r * 12288 + shi * DM; const float* sc = mod + (size_t)r * 12288 + sci * DM;
        f32x4 v[8]; float ss = 0.f;
        if (xb) { u32x2 w[8];
#pragma unroll
            for (int c = 0; c < 8; ++c) w[c] = *(const u32x2*)(xb + (size_t)row * DM + c * 256 + lane * 4);
#pragma unroll
            for (int c = 0; c < 8; ++c) v[c] = (f32x4){bflo(w[c].x), bfhi(w[c].x), bflo(w[c].y), bfhi(w[c].y)};
        } else {
#pragma unroll
            for (int c = 0; c < 8; ++c) v[c] = *(const f32x4*)(src + c * 256 + lane * 4); }
#pragma unroll
        for (int c = 0; c < 8; ++c) ss += v[c][0] * v[c][0] + v[c][1] * v[c][1] + v[c][2] * v[c][2] + v[c][3] * v[c][3];
        ss = wave_sum(ss);
        const float rs = rsqrtf(ss * (1.f / DM) + EPS);
        float am = 0.f;
#pragma unroll
        for (int c = 0; c < 8; ++c) {
            const int i = c * 256 + lane * 4;
            const f32x4 gv = *(const f32x4*)(g + i), sv = *(const f32x4*)(sc + i), hv = *(const f32x4*)(sh + i);
            f32x4 y;
#pragma unroll
            for (int q = 0; q < 4; ++q) y[q] = (v[c][q] * rs * gv[q]) * (1.f + sv[q]) + hv[q];
            if (H) { u32x2 w; w.x = cvtpk(y[0], y[1]); w.y = cvtpk(y[2], y[3]); *(u32x2*)(H + (size_t)row * DM + i) = w; }
            if (HI8) { v[c] = y; am = fmaxf(am, fmaxf(fmaxf(fabsf(y[0]), fabsf(y[1])), fmaxf(fabsf(y[2]), fabsf(y[3])))); }
            if (H8) {
#pragma unroll
                for (int q = 0; q < 4; ++q) y[q] = fminf(fmaxf(y[q], -448.f), 448.f);
                int d = 0; d = __builtin_amdgcn_cvt_pk_fp8_f32(y[0], y[1], d, false); d = __builtin_amdgcn_cvt_pk_fp8_f32(y[2], y[3], d, true);
                *(unsigned*)(H8 + (size_t)row * DM + i) = (unsigned)d;
            }
        }
        if (HI8) {
            am = fmaxf(am, xshf<1>(am)); am = fmaxf(am, xshf<2>(am)); am = fmaxf(am, xshf<4>(am)); am = fmaxf(am, xshf<8>(am)); am = fmaxf(am, xshf<16>(am)); am = fmaxf(am, xshf<32>(am));
            const float qs = am > 0.f ? 127.f / am : 1.f;
#pragma unroll
            for (int c = 0; c < 8; ++c) *(unsigned*)(HI8 + (size_t)row * DM + c * 256 + lane * 4) = pack_i8x4(v[c][0] * qs, v[c][1] * qs, v[c][2] * qs, v[c][3] * qs);
            if (lane == 0) HSC[row] = am > 0.f ? am * (1.f / 127.f) : 1.f;
        }
    }
}

DEV void unpack8(const u32x4 w, float (&v)[8]) { v[0] = bflo(w.x); v[1] = bfhi(w.x); v[2] = bflo(w.y); v[3] = bfhi(w.y); v[4] = bflo(w.z); v[5] = bfhi(w.z); v[6] = bflo(w.w); v[7] = bfhi(w.w); }
DEV u32x4 pack8(const float (&v)[8]) { u32x4 o; o.x = cvtpk(v[0], v[1]); o.y = cvtpk(v[2], v[3]); o.z = cvtpk(v[4], v[5]); o.w = cvtpk(v[6], v[7]); return o; }
DEV float sumsq8(const float (&v)[8]) { float s = 0.f;
#pragma unroll
    for (int q = 0; q < 8; ++q) s += v[q] * v[q];
    return s; }
template <int PM, int SOFF> DEV void rope8(float (&v)[8], const float* tab, bool hiq) {
    const f32x4 c0 = *(const f32x4*)tab, c1 = *(const f32x4*)(tab + 4), s0 = *(const f32x4*)(tab + SOFF), s1 = *(const f32x4*)(tab + SOFF + 4);
#pragma unroll
    for (int q = 0; q < 8; ++q) { const float pt = xshf<PM>(v[q]); const float cs = q < 4 ? c0[q & 3] : c1[q & 3], sn = q < 4 ? s0[q & 3] : s1[q & 3];
        v[q] = v[q] * cs + (hiq ? pt : -pt) * sn; }
}
struct Prep1Row { u32x4 a[7]; u32x2 b; };
DEV void prep1_load(const bf16_t* pr, int lane, bool lat, Prep1Row& R) {
    R.a[0] = *(const u32x4*)(pr + C_DAQ + lane * 8); R.a[1] = *(const u32x4*)(pr + C_DAK + lane * 8);
    R.a[2] = lat ? *(const u32x4*)(pr + C_RTQ + lane * 8) : (u32x4){0u, 0u, 0u, 0u}; R.a[3] = *(const u32x4*)(pr + C_RTK + lane * 8);
    R.a[4] = *(const u32x4*)(pr + C_NAQ + lane * 8); R.a[5] = *(const u32x4*)(pr + C_NAK + lane * 8);
    R.a[6] = *(const u32x4*)(pr + C_MCQ + lane * 8); R.b = *(const u32x2*)(pr + C_MKV + lane * 4);
}
DEV void phase_prep1(const P& p, int l, int bid, int nb) {
    const int tix = lid(); const int wid = tix >> 6, lane = tix & 63;
    const float* ra = wsf(p, OFF_ROPEA); const float* rr = wsf(p, OFF_ROPER);
    const float* dag = p.diff_qk_g + l * 128; const float* nag = p.na_qk_g + l * 128;
    int row = bid * 8 + wid;
    Prep1Row cur, nxt;
    if (row < TA) prep1_load(wsb(p, OFF_PROJ) + (size_t)row * INP, lane, row < TL, cur);
#pragma unroll 1
    for (; row < TA; row += nb * 8) {
        const int nrow = row + nb * 8;
        if (nrow < TA) prep1_load(wsb(p, OFF_PROJ) + (size_t)nrow * INP, lane, nrow < TL, nxt);
        bf16_t* pr = wsb(p, OFF_PROJ) + (size_t)row * INP;
        const bool lat = row < TL; const int s = row & 2047, gr = s >> 6, gc = s & 63;
        { const int ci = lane & 7;
#pragma unroll
          for (int it = 0; it < 2; ++it) {
            u32x4* e = (u32x4*)(pr + (it ? C_DAK : C_DAQ) + lane * 8); float v[8]; unpack8(cur.a[it], v);
            float ss = sumsq8(v); ss += xshf<1>(ss); ss += xshf<2>(ss); ss += xshf<4>(ss);
            const float rs = rsqrtf(ss * (1.f / 64.f) + EPS); const float* g = dag + it * 64 + ci * 8;
#pragma unroll
            for (int q = 0; q < 8; ++q) v[q] = v[q] * rs * g[q];
            if (lat) rope8<2, 1024>(v, ra + (ci < 4 ? gr : gc) * 16 + (ci & 1) * 8, (ci & 2) != 0);
            *e = pack8(v);
          } }
        { const int ci = lane & 15;
#pragma unroll
          for (int it = 0; it < 2; ++it) {
            if (it == 0 && !lat) continue;
            u32x4* e = (u32x4*)(pr + (it ? C_RTK : C_RTQ) + lane * 8); float v[8]; unpack8(cur.a[2 + it], v);
            if (it) {
#pragma unroll
                for (int q = 0; q < 8; ++q) v[q] *= 0.08838834764831845f; }
            if (lat) rope8<4, 2048>(v, rr + (ci < 8 ? gr : gc) * 32 + (ci & 3) * 8, (ci & 4) != 0);
            *e = pack8(v);
          } }
        { const int ci = lane & 7;
#pragma unroll
          for (int it = 0; it < 2; ++it) {
            u32x4* e = (u32x4*)(pr + (it ? C_NAK : C_NAQ) + lane * 8); float v[8]; unpack8(cur.a[4 + it], v);
            float ss = sumsq8(v); ss += xshf<1>(ss); ss += xshf<2>(ss); ss += xshf<4>(ss);
            const float rs = rsqrtf(ss * (1.f / 64.f) + EPS); const float* g = nag + it * 64 + ci * 8;
#pragma unroll
            for (int q = 0; q < 8; ++q) v[q] = v[q] * rs * g[q];
            *e = pack8(v);
          } }
        {
            u32x4* e = (u32x4*)(pr + C_MCQ + lane * 8); float v[8]; unpack8(cur.a[6], v);
            const float rs = rsqrtf(wave_sum(sumsq8(v)) * (1.f / 512.f) + EPS);
            const float* g = p.mla_q_norm_g + l * 512 + lane * 8;
#pragma unroll
            for (int q = 0; q < 8; ++q) v[q] = v[q] * rs * g[q];
            *e = pack8(v);
        }
        {
            u32x2* e = (u32x2*)(pr + C_MKV + lane * 4); const u32x2 w = cur.b;
            float v[4] = {bflo(w.x), bfhi(w.x), bflo(w.y), bfhi(w.y)};
            float ss = v[0] * v[0] + v[1] * v[1] + v[2] * v[2] + v[3] * v[3];
            ss = wave_sum(ss); const float rs = rsqrtf(ss * (1.f / 256.f) + EPS);
            const float* g = p.mla_kv_norm_g + l * 256 + lane * 4;
#pragma unroll
            for (int q = 0; q < 4; ++q) v[q] = v[q] * rs * g[q];
            u32x2 o; o.x = cvtpk(v[0], v[1]); o.y = cvtpk(v[2], v[3]); *e = o;
        }
#pragma unroll
        for (int q = 0; q < 7; ++q) cur.a[q] = nxt.a[q];
        cur.b = nxt.b;
    }
}

DEV void prep2_load(const P& p, int row, int ci, int hsel, bool act, u32x4 (&w)[2][2]) {
    const bf16_t* qm = wsb(p, OFF_QM) + (size_t)row * 768; const bf16_t* kv = wsb(p, OFF_KVM) + (size_t)row * 1024; const bf16_t* kr = wsb(p, OFF_PROJ) + (size_t)row * INP + C_MKR;
#pragma unroll
    for (int hp = 0; hp < 2; ++hp) { const int h = hp * 2 + hsel;
        w[hp][0] = (u32x4){0u, 0u, 0u, 0u}; w[hp][1] = (u32x4){0u, 0u, 0u, 0u};
        if (act) { w[hp][0] = *(const u32x4*)(qm + h * 192 + ci * 8); w[hp][1] = ci < 16 ? *(const u32x4*)(kv + h * 256 + ci * 8) : *(const u32x4*)(kr + (ci - 16) * 8); } }
}
DEV void phase_prep2(const P& p, int l, int bid, int nb) {
    const int tix = lid(); const int wid = tix >> 6, lane = tix & 63;
    const float* ra = wsf(p, OFF_ROPEA);
    const float* gq = p.mla_qk_g + l * 384; const float* gk = gq + 192;
    const int ci = lane & 31, hsel = lane >> 5; const bool act = ci < 24; const int cr = ci - 16;
    int row = bid * 8 + wid;
    u32x4 cur[2][2], nxt[2][2];
    if (row < TA) prep2_load(p, row, ci, hsel, act, cur);
#pragma unroll 1
    for (; row < TA; row += nb * 8) {
        const int nrow = row + nb * 8;
        if (nrow < TA) prep2_load(p, nrow, ci, hsel, act, nxt);
        const bool lat = row < TL; const int s = row & 2047, gr = s >> 6, gc = s & 63;
        bf16_t* qm = wsb(p, OFF_QM) + (size_t)row * 768; bf16_t* km = wsb(p, OFF_KM) + (size_t)row * 768;
        const float* rtab = ra + ((cr & 7) < 4 ? gr : gc) * 16 + (cr & 1) * 8;
#pragma unroll
        for (int hp = 0; hp < 2; ++hp) {
            const int h = hp * 2 + hsel;
            {   float v[8]; unpack8(cur[hp][0], v);
                float ss = sumsq8(v); ss += xshf<1>(ss); ss += xshf<2>(ss); ss += xshf<4>(ss); ss += xshf<8>(ss); ss += xshf<16>(ss);
                const float rs = rsqrtf(ss * (1.f / 192.f) + EPS); const float* g = gq + (act ? ci : 0) * 8;
#pragma unroll
                for (int q = 0; q < 8; ++q) v[q] = v[q] * rs * g[q];
                if (lat) { float r8[8];
#pragma unroll
                    for (int q = 0; q < 8; ++q) r8[q] = v[q];
                    rope8<2, 1024>(r8, rtab, (cr & 2) != 0);
                    if (ci >= 16) {
#pragma unroll
                        for (int q = 0; q < 8; ++q) v[q] = r8[q]; } }
                if (act) *(u32x4*)(qm + h * 192 + ci * 8) = pack8(v); }
            {   float v[8]; unpack8(cur[hp][1], v);
                float ss = sumsq8(v); ss += xshf<1>(ss); ss += xshf<2>(ss); ss += xshf<4>(ss); ss += xshf<8>(ss); ss += xshf<16>(ss);
                const float rs = rsqrtf(ss * (1.f / 192.f) + EPS); const float* g = gk + (act ? ci : 0) * 8;
#pragma unroll
                for (int q = 0; q < 8; ++q) v[q] = v[q] * rs * g[q];
                if (lat) { float r8[8];
#pragma unroll
                    for (int q = 0; q < 8; ++q) r8[q] = v[q];
                    rope8<2, 1024>(r8, rtab, (cr & 2) != 0);
                    if (ci >= 16) {
#pragma unroll
                        for (int q = 0; q < 8; ++q) v[q] = r8[q]; } }
                if (act) *(u32x4*)(km + h * 192 + ci * 8) = pack8(v); }
        }
#pragma unroll
        for (int hp = 0; hp < 2; ++hp) { cur[hp][0] = nxt[hp][0]; cur[hp][1] = nxt[hp][1]; }
    }
}

namespace at {
#define SBAR() __builtin_amdgcn_sched_barrier(0)
constexpr float THR = 8.f;
DEV int crow(int r, int hi) { return (r & 3) + 8 * (r >> 2) + 4 * hi; }
template <int N> DEV void wait_vm() { asm volatile("s_waitcnt vmcnt(%0)" ::"n"(N) : "memory"); }
template <int KSW> DEV int kaddr(int row, int ch) {
    if (KSW == 0) return row * 256 + ((ch ^ (row & 15)) << 4);
    if (KSW == 1) return row * 384 + ((ch ^ ((row >> 1) & 7)) << 4);
    return row * 512 + ((ch ^ (row & 15)) << 4);
}
DEV void partialSM(f32x16& p0, f32x16& p1, float& m_reg, float& mn, float& alpha, float C, float thr_raw) {
    float pmax = p0[0];
#pragma unroll
    for (int r = 1; r < 16; ++r) pmax = fmaxf(pmax, p0[r]);
#pragma unroll
    for (int r = 0; r < 16; ++r) pmax = fmaxf(pmax, p1[r]);
    { auto rr = __builtin_amdgcn_permlane32_swap(__float_as_uint(pmax), __float_as_uint(pmax), false, false);
      pmax = fmaxf(__uint_as_float(rr[0]), __uint_as_float(rr[1])); }
    if (__builtin_expect(__all(pmax - m_reg <= thr_raw), 1)) { mn = m_reg; alpha = 1.f; }
    else { mn = fmaxf(m_reg, pmax); alpha = __builtin_amdgcn_exp2f((m_reg - mn) * C); m_reg = mn; }
    const float mnC = -mn * C;
#pragma unroll
    for (int r = 0; r < 16; ++r) p0[r] = fmaf(p0[r], C, mnC);
#pragma unroll
    for (int r = 0; r < 16; ++r) p1[r] = fmaf(p1[r], C, mnC);
#pragma unroll
    for (int r = 0; r < 16; ++r) p0[r] = __builtin_amdgcn_exp2f(p0[r]);
}
DEV void finishSM(f32x16& p0, f32x16& p1, float alpha, float& l_reg, bf16x8& pa0, bf16x8& pa1, bf16x8& pa2, bf16x8& pa3) {
#pragma unroll
    for (int r = 0; r < 16; ++r) p1[r] = __builtin_amdgcn_exp2f(p1[r]);
    float ps = 0;
#pragma unroll
    for (int r = 0; r < 16; ++r) ps += p0[r];
#pragma unroll
    for (int r = 0; r < 16; ++r) ps += p1[r];
    { auto rr = __builtin_amdgcn_permlane32_swap(__float_as_uint(ps), __float_as_uint(ps), false, false);
      ps = __uint_as_float(rr[0]) + __uint_as_float(rr[1]); }
    l_reg = l_reg * alpha + ps;
#define PK4(Pq, BASE, OUT) do { unsigned a0 = cvtpk(Pq[BASE + 0], Pq[BASE + 1]), a1 = cvtpk(Pq[BASE + 2], Pq[BASE + 3]);   \
    unsigned b0 = cvtpk(Pq[BASE + 4], Pq[BASE + 5]), b1 = cvtpk(Pq[BASE + 6], Pq[BASE + 7]);                              \
    auto r0 = __builtin_amdgcn_permlane32_swap(a0, b0, false, false); auto r1 = __builtin_amdgcn_permlane32_swap(a1, b1, false, false); \
    u32x4 w = {r0[0], r1[0], r0[1], r1[1]}; OUT = *reinterpret_cast<bf16x8*>(&w); } while (0)
    PK4(p0, 0, pa0); PK4(p0, 8, pa1); PK4(p1, 0, pa2); PK4(p1, 8, pa3);
#undef PK4
}
template <int ND0, int KSW>
DEV void qkt(f32x16& p0, f32x16& p1, const char* Ks, const bf16x8* qr, int r32, int hi, int chunk0) {
    p0 = f32x16{}; p1 = f32x16{};
#pragma unroll
    for (int d0 = 0; d0 < ND0; ++d0) { const int ch = chunk0 + d0 * 2 + hi;
        const bf16x8 b0 = *reinterpret_cast<const bf16x8*>(Ks + kaddr<KSW>(r32, ch));
        const bf16x8 b1 = *reinterpret_cast<const bf16x8*>(Ks + kaddr<KSW>(32 + r32, ch));
        p0 = __builtin_amdgcn_mfma_f32_32x32x16_bf16(b0, qr[d0], p0, 0, 0, 0);
        p1 = __builtin_amdgcn_mfma_f32_32x32x16_bf16(b1, qr[d0], p1, 0, 0, 0); }
}
DEV int v_st(int k, int c) { const int kk = (k & ~0xC) | ((k & 4) << 1) | ((k & 8) >> 1); return ((kk >> 3) * 4 + (c >> 5)) * 512 + ((kk & 7) * 32 + (c & 31)) * 2; }
DEV int v_rd_base(int lane) { return ((lane & 3) << 3) | (((lane >> 2) & 3) << 6) | (((lane >> 4) & 1) << 5) | (((lane >> 5) & 1) << 8); }
constexpr int v_rd_off(int d0, int ks, int half) { return d0 * 512 + ks * 4096 + half * 2048; }
template <int OFF> DEV s16x4 tr_read(int vb) { s16x4 r; asm volatile("ds_read_b64_tr_b16 %0, %1 offset:%2" : "=&v"(r) : "v"(vb), "i"(OFF) : "memory"); return r; }
template <int D0> DEV void pv_one(f32x16& od, int vb, bf16x8 pa0, bf16x8 pa1, bf16x8 pa2, bf16x8 pa3) {
    const s16x4 l0 = tr_read<v_rd_off(D0, 0, 0)>(vb), h0 = tr_read<v_rd_off(D0, 0, 1)>(vb), l1 = tr_read<v_rd_off(D0, 1, 0)>(vb), h1 = tr_read<v_rd_off(D0, 1, 1)>(vb);
    const s16x4 l2 = tr_read<v_rd_off(D0, 2, 0)>(vb), h2 = tr_read<v_rd_off(D0, 2, 1)>(vb), l3 = tr_read<v_rd_off(D0, 3, 0)>(vb), h3 = tr_read<v_rd_off(D0, 3, 1)>(vb);
    asm volatile("s_waitcnt lgkmcnt(0)" ::: "memory"); SBAR();
#define PK(L, H) (bf16x8){L[0], L[1], L[2], L[3], H[0], H[1], H[2], H[3]}
    od = __builtin_amdgcn_mfma_f32_32x32x16_bf16(pa0, PK(l0, h0), od, 0, 0, 0);
    od = __builtin_amdgcn_mfma_f32_32x32x16_bf16(pa1, PK(l1, h1), od, 0, 0, 0);
    od = __builtin_amdgcn_mfma_f32_32x32x16_bf16(pa2, PK(l2, h2), od, 0, 0, 0);
    od = __builtin_amdgcn_mfma_f32_32x32x16_bf16(pa3, PK(l3, h3), od, 0, 0, 0);
#undef PK
}
DEV void pv_d4(f32x16* o, int vb, bf16x8 pa0, bf16x8 pa1, bf16x8 pa2, bf16x8 pa3) {
    pv_one<0>(o[0], vb, pa0, pa1, pa2, pa3); pv_one<1>(o[1], vb, pa0, pa1, pa2, pa3); pv_one<2>(o[2], vb, pa0, pa1, pa2, pa3); pv_one<3>(o[3], vb, pa0, pa1, pa2, pa3);
}

struct KV { const bf16_t *Kc, *Kl, *Vc, *Vl; long ldk, ldv; int nct; };

template <int ND0, int KSW, int KW16, int NKC, int SDEPTH>
DEV void attn_body(const int tid, const bf16x8* qr, const KV kv, int NT, float C, int chunk0, char* lds, f32x16 (&o)[4], float& l_reg, float* al_l) {
    constexpr int SHM_V = 16384, SHM_K = 64 * KW16 * 16;
    const int lane = tid & 63, r32 = lane & 31, hi = lane >> 5;
    char* V_lds = lds; char* K_lds = lds + 2 * SHM_V;
    float m_reg = -1e30f; l_reg = 0.f;
#pragma unroll
    for (int d = 0; d < 4; ++d) o[d] = f32x16{};
    const float thr_raw = THR * 1.4426950408889634f / C;
    const int vb0 = (int)(uintptr_t)V_lds + v_rd_base(lane);
    struct Slot { bf16x8 k[NKC]; bf16x8 v[2]; } sr_[SDEPTH];
#define SLOAD(i, T) do { const int _t = (T); const bf16_t* _kb = _t < kv.nct ? kv.Kc + (long)_t * 64 * kv.ldk : kv.Kl + (long)(_t - kv.nct) * 64 * kv.ldk;  \
        const bf16_t* _vb = _t < kv.nct ? kv.Vc + (long)_t * 64 * kv.ldv : kv.Vl + (long)(_t - kv.nct) * 64 * kv.ldv;                                       \
        _Pragma("unroll") for (int _q = 0; _q < 2; ++_q) { const int _id = tid + 512 * _q; sr_[i].v[_q] = *(const bf16x8*)(_vb + (long)(_id >> 4) * kv.ldv + (_id & 15) * 8); } \
        _Pragma("unroll") for (int _q = 0; _q < NKC; ++_q) { const int _id = tid + 512 * _q; sr_[i].k[_q] = *(const bf16x8*)(_kb + (long)(_id / KW16) * kv.ldk + (_id % KW16) * 8); } } while (0)
#define SWRITE(b, i) do {                                                                                                                                     \
        _Pragma("unroll") for (int _q = 0; _q < 2; ++_q) { const int _id = tid + 512 * _q; *(bf16x8*)(V_lds + (b) * SHM_V + v_st(_id >> 4, (_id & 15) * 8)) = sr_[i].v[_q]; } \
        _Pragma("unroll") for (int _q = 0; _q < NKC; ++_q) { const int _id = tid + 512 * _q; *(bf16x8*)(K_lds + (b) * SHM_K + kaddr<KSW>(_id / KW16, _id % KW16)) = sr_[i].k[_q]; } } while (0)
#define SWAIT() do { if constexpr (SDEPTH == 2) wait_vm<2 + NKC>(); else wait_vm<0>(); } while (0)
#define RESC(a) do { if (__any((a) < 1.f)) { if (hi == 0) al_l[r32] = (a); asm volatile("s_waitcnt lgkmcnt(0)" ::: "memory"); \
        _Pragma("unroll") for (int d = 0; d < 4; ++d) _Pragma("unroll") for (int r = 0; r < 16; ++r) o[d][r] *= al_l[crow(r, hi)]; } } while (0)
    f32x16 pA0, pA1, pB0, pB1; float mnA, mnB, alA, alB; bf16x8 pa0, pa1, pa2, pa3;
    constexpr int SE = 0, SO = SDEPTH - 1;
    SLOAD(SE, 0); wait_vm<0>(); SWRITE(0, SE); __syncthreads();
    qkt<ND0, KSW>(pA0, pA1, K_lds, qr, r32, hi, chunk0); partialSM(pA0, pA1, m_reg, mnA, alA, C, thr_raw);
    SLOAD(SO, 1); if constexpr (SDEPTH == 2) { if (2 < NT) SLOAD(SE, 2); }
    SWAIT(); SWRITE(1, SO); __syncthreads();
    for (int j = 1; j + 1 < NT; j += 2) {
        SBAR(); qkt<ND0, KSW>(pB0, pB1, K_lds + SHM_K, qr, r32, hi, chunk0);
        finishSM(pA0, pA1, alA, l_reg, pa0, pa1, pa2, pa3); SBAR();
        SLOAD(SO, j + SDEPTH); SBAR();
        pv_d4(o, vb0, pa0, pa1, pa2, pa3); partialSM(pB0, pB1, m_reg, mnB, alB, C, thr_raw);
        __syncthreads(); SWAIT(); SWRITE(0, SE);
        RESC(alB); __syncthreads();
        SBAR(); qkt<ND0, KSW>(pA0, pA1, K_lds, qr, r32, hi, chunk0);
        finishSM(pB0, pB1, alB, l_reg, pa0, pa1, pa2, pa3); SBAR();
        if (SDEPTH == 1 || j + 3 < NT) SLOAD(SE, j + 1 + SDEPTH); SBAR();
        pv_d4(o, vb0 + SHM_V, pa0, pa1, pa2, pa3); partialSM(pA0, pA1, m_reg, mnA, alA, C, thr_raw);
        __syncthreads(); SWAIT(); SWRITE(1, SO);
        RESC(alA); __syncthreads();
    }
    SBAR(); qkt<ND0, KSW>(pB0, pB1, K_lds + SHM_K, qr, r32, hi, chunk0);
    finishSM(pA0, pA1, alA, l_reg, pa0, pa1, pa2, pa3); SBAR();
    pv_d4(o, vb0, pa0, pa1, pa2, pa3); partialSM(pB0, pB1, m_reg, mnB, alB, C, thr_raw);
    __syncthreads(); RESC(alB);
    finishSM(pB0, pB1, alB, l_reg, pa0, pa1, pa2, pa3); SBAR();
    pv_d4(o, vb0 + SHM_V, pa0, pa1, pa2, pa3);
#undef SLOAD
#undef SWRITE
#undef SWAIT
#undef RESC
}
template <int ND0, int KSW, int KW16, int NKC>
DEV void attn_body1(const int tid, const bf16x8* qr, const KV kv, int NT, float C, int chunk0, char* lds, f32x16 (&o)[4], float& l_reg, float* al_l) {
    constexpr int SHM_V = 16384, SHM_K = 64 * KW16 * 16;
    const int lane = tid & 63, r32 = lane & 31, hi = lane >> 5;
    char* V_lds = lds; char* K_lds = lds + 2 * SHM_V;
    float m_reg = -1e30f; l_reg = 0.f;
#pragma unroll
    for (int d = 0; d < 4; ++d) o[d] = f32x16{};
    const float thr_raw = THR * 1.4426950408889634f / C;
    const int vb0 = (int)(uintptr_t)V_lds + v_rd_base(lane);
    bf16x8 sk[NKC], sv[2];
#define SLOAD1(T) do { const int _t = (T); const bf16_t* _kb = _t < kv.nct ? kv.Kc + (long)_t * 64 * kv.ldk : kv.Kl + (long)(_t - kv.nct) * 64 * kv.ldk;  \
        const bf16_t* _vb = _t < kv.nct ? kv.Vc + (long)_t * 64 * kv.ldv : kv.Vl + (long)(_t - kv.nct) * 64 * kv.ldv;                                    \
        _Pragma("unroll") for (int _q = 0; _q < 2; ++_q) { const int _id = tid + 512 * _q; sv[_q] = *(const bf16x8*)(_vb + (long)(_id >> 4) * kv.ldv + (_id & 15) * 8); } \
        _Pragma("unroll") for (int _q = 0; _q < NKC; ++_q) { const int _id = tid + 512 * _q; sk[_q] = *(const bf16x8*)(_kb + (long)(_id / KW16) * kv.ldk + (_id % KW16) * 8); } } while (0)
#define SWRITE1(b) do {                                                                                                                                    \
        _Pragma("unroll") for (int _q = 0; _q < 2; ++_q) { const int _id = tid + 512 * _q; *(bf16x8*)(V_lds + (b) * SHM_V + v_st(_id >> 4, (_id & 15) * 8)) = sv[_q]; } \
        _Pragma("unroll") for (int _q = 0; _q < NKC; ++_q) { const int _id = tid + 512 * _q; *(bf16x8*)(K_lds + (b) * SHM_K + kaddr<KSW>(_id / KW16, _id % KW16)) = sk[_q]; } } while (0)
    f32x16 p0, p1; float mn, al; bf16x8 pa0, pa1, pa2, pa3;
    SLOAD1(0); wait_vm<0>(); SWRITE1(0); __syncthreads();
    for (int j = 0; j < NT; ++j) {
        const int bsel = j & 1;
        if (j + 1 < NT) SLOAD1(j + 1);
        SBAR(); qkt<ND0, KSW>(p0, p1, K_lds + bsel * SHM_K, qr, r32, hi, chunk0);
        partialSM(p0, p1, m_reg, mn, al, C, thr_raw);
        if (__any(al < 1.f)) { if (hi == 0) al_l[r32] = al; asm volatile("s_waitcnt lgkmcnt(0)" ::: "memory");
#pragma unroll
            for (int d = 0; d < 4; ++d)
#pragma unroll
                for (int r = 0; r < 16; ++r) o[d][r] *= al_l[crow(r, hi)]; }
        finishSM(p0, p1, al, l_reg, pa0, pa1, pa2, pa3); SBAR();
        pv_d4(o, vb0 + bsel * SHM_V, pa0, pa1, pa2, pa3);
        if (j + 1 < NT) { wait_vm<0>(); SWRITE1(bsel ^ 1); }
        __syncthreads();
    }
#undef SLOAD1
#undef SWRITE1
}
}

DEV void da_unit(const P& p, int l, int b, int h, int qtok0  , bool ctxq, char* smem) {
    const int tid = lid();
    const int wid = tid >> 6, lane = tid & 63, r32 = lane & 31, hi = lane >> 5, sub = wid >> 2;
    const bf16_t* PR = wsb(p, OFF_PROJ);
    bf16x8 qr[4];
    { const bf16_t* q = PR + (size_t)(qtok0 + (wid & 3) * 32 + r32) * INP + C_DAQ + h * 128 + sub * 64 + hi * 8;
#pragma unroll
      for (int d0 = 0; d0 < 4; ++d0) qr[d0] = *(const bf16x8*)(q + d0 * 16); }
    at::KV kv; kv.ldk = INP; kv.ldv = INP; kv.nct = 4;
    kv.Kc = PR + (size_t)(TL + b * CTX) * INP + C_DAK + h * 128; kv.Vc = PR + (size_t)(TL + b * CTX) * INP + C_DAV + h * 128;
    kv.Kl = PR + (size_t)(b * SEQ) * INP + C_DAK + h * 128; kv.Vl = PR + (size_t)(b * SEQ) * INP + C_DAV + h * 128;
    float* wsl = (float*)(smem + 65536) + wid * 64; float* li_l = wsl; float* al_l = wsl + 32;
    f32x16 o[4]; float l_reg;
    at::attn_body<4, 0, 16, 2, 2>(tid, qr, kv, ctxq ? 4 : 36, 0.125f * 1.4426950408889634f, sub * 8, smem, o, l_reg, al_l);
    if (hi == 0) li_l[r32] = l_reg; asm volatile("s_waitcnt lgkmcnt(0)" ::: "memory");
#pragma unroll
    for (int r = 0; r < 16; ++r) { const float rl = __builtin_amdgcn_rcpf(li_l[at::crow(r, hi)]);
#pragma unroll
        for (int d = 0; d < 4; ++d) o[d][r] *= rl; }
    __syncthreads();
    float* xch = (float*)smem;
    if (wid >= 4) {
#pragma unroll
        for (int d = 0; d < 4; ++d)
#pragma unroll
            for (int r = 0; r < 16; ++r) xch[((wid - 4) * 64 + d * 16 + r) * 64 + lane] = o[d][r];
    }
    __syncthreads();
    if (wid < 4) {
        const float lam = wsf(p, OFF_MISC)[l * 2], om = 1.f - wsf(p, OFF_MISC)[l * 2 + 1];
        const float* sg = p.diff_sub_g + l * 128;
        float ss[16];
#pragma unroll
        for (int r = 0; r < 16; ++r) ss[r] = 0.f;
#pragma unroll
        for (int d = 0; d < 4; ++d)
#pragma unroll
            for (int r = 0; r < 16; ++r) { const float y = o[d][r] - lam * xch[(wid * 64 + d * 16 + r) * 64 + lane]; o[d][r] = y; ss[r] += y * y; }
#pragma unroll
        for (int r = 0; r < 16; ++r) {
            ss[r] += xshf<1>(ss[r]); ss[r] += xshf<2>(ss[r]); ss[r] += xshf<4>(ss[r]); ss[r] += xshf<8>(ss[r]); ss[r] += xshf<16>(ss[r]);
            ss[r] = rsqrtf(ss[r] * (1.f / 128.f) + EPS) * om;
        }
        bf16_t* Y = wsb(p, OFF_Y) + (size_t)(qtok0 + wid * 32) * DM + 0 + h * 128;
#pragma unroll
        for (int d = 0; d < 4; ++d) { const float g = sg[d * 32 + r32];
#pragma unroll
            for (int r = 0; r < 16; ++r) Y[(size_t)at::crow(r, hi) * DM + d * 32 + r32] = f2bf(o[d][r] * ss[r] * g); }
    }
    __syncthreads();
}
DEV void mla_unit(const P& p, int b, int h, int qtok0, bool ctxq, char* smem) {
    const int tid = lid();
    const int wid = tid >> 6, lane = tid & 63, r32 = lane & 31, hi = lane >> 5;
    bf16x8 qr[12];
    { const bf16_t* q = wsb(p, OFF_QM) + (size_t)(qtok0 + wid * 32 + r32) * 768 + h * 192 + hi * 8;
#pragma unroll
      for (int d0 = 0; d0 < 12; ++d0) qr[d0] = *(const bf16x8*)(q + d0 * 16); }
    const bf16_t* KM = wsb(p, OFF_KM); const bf16_t* KVM = wsb(p, OFF_KVM);
    at::KV kv; kv.ldk = 768; kv.ldv = 1024; kv.nct = 4;
    kv.Kc = KM + (size_t)(TL + b * CTX) * 768 + h * 192; kv.Vc = KVM + (size_t)(TL + b * CTX) * 1024 + h * 256 + 128;
    kv.Kl = KM + (size_t)(b * SEQ) * 768 + h * 192; kv.Vl = KVM + (size_t)(b * SEQ) * 1024 + h * 256 + 128;
    float* wsl = (float*)(smem + 32768 + 49152) + wid * 64; float* li_l = wsl; float* al_l = wsl + 32;
    f32x16 o[4]; float l_reg;
    at::attn_body1<12, 1, 24, 3>(tid, qr, kv, ctxq ? 4 : 36, 0.07216878364870322f * 1.4426950408889634f, 0, smem, o, l_reg, al_l);
    if (hi == 0) li_l[r32] = l_reg; asm volatile("s_waitcnt lgkmcnt(0)" ::: "memory");
    bf16_t* Y = wsb(p, OFF_Y) + (size_t)(qtok0 + wid * 32) * DM + 1536 + h * 128;
#pragma unroll
    for (int r = 0; r < 16; ++r) { const float rl = __builtin_amdgcn_rcpf(li_l[at::crow(r, hi)]);
#pragma unroll
        for (int d = 0; d < 4; ++d) Y[(size_t)at::crow(r, hi) * DM + d * 32 + r32] = f2bf(o[d][r] * rl); }
    __syncthreads();
}

DEV void pack_p(const f32x16& p0, const f32x16& p1, bf16x8& pa0, bf16x8& pa1, bf16x8& pa2, bf16x8& pa3) {
#define PK4(Pq, BASE, OUT) do { unsigned a0 = cvtpk(Pq[BASE + 0], Pq[BASE + 1]), a1 = cvtpk(Pq[BASE + 2], Pq[BASE + 3]);   \
    unsigned b0 = cvtpk(Pq[BASE + 4], Pq[BASE + 5]), b1 = cvtpk(Pq[BASE + 6], Pq[BASE + 7]);                              \
    auto r0 = __builtin_amdgcn_permlane32_swap(a0, b0, false, false); auto r1 = __builtin_amdgcn_permlane32_swap(a1, b1, false, false); \
    u32x4 w = {r0[0], r1[0], r0[1], r1[1]}; OUT = *reinterpret_cast<bf16x8*>(&w); } while (0)
    PK4(p0, 0, pa0); PK4(p0, 8, pa1); PK4(p1, 0, pa2); PK4(p1, 8, pa3);
#undef PK4
}
DEV void na_unit(const P& p, int l, int b, int r, int hg, bool ctxq, char* smem) {
    const int tid = lid();
    const int wid = tid >> 6, lane = tid & 63, r32 = lane & 31, hi = lane >> 5, hh = wid >> 1, qh = wid & 1;
    const bf16_t* PR = wsb(p, OFF_PROJ);
    const int qtok = ctxq ? TL + b * CTX + r * 64 : b * SEQ + r * 64;
    bf16x8 qr[4];
    { const bf16_t* q = PR + (size_t)(qtok + qh * 32 + r32) * INP + C_NAQ + (hg * 4 + hh) * 64 + hi * 8;
#pragma unroll
      for (int d0 = 0; d0 < 4; ++d0) qr[d0] = *(const bf16x8*)(q + d0 * 16); }
    char* Ks = smem; char* Vs = smem + 32768; float* bias = (float*)(smem + 65536); float* al_l = (float*)(smem + 65536 + 4096) + wid * 64; float* li_l = al_l + 32;
    const int rs = min(max(r - 4, 0), 24), nloc = ctxq ? 0 : 8, NT = nloc + 4;
    __syncthreads();
    if (!ctxq) for (int e = tid; e < 1024; e += 512) { const int h_ = e >> 8, i = (e >> 5) & 7, dc = e & 31, dr = rs + i - r + 7;
        bias[e] = dc < 31 ? p.na_rpb[(((size_t)l * 8 + hg * 4 + h_) * 15 + dr) * 31 + dc] * 1.4426950408889634f : 0.f; }
    constexpr float C = 0.125f * 1.4426950408889634f;
    float m_reg = -1e30f, l_reg = 0.f; f32x16 o[2] = {};
    const int vb = (int)(uintptr_t)Vs + (hh >> 1) * 16384 + (hh & 1) * 1024 + at::v_rd_base(lane);
    bf16x8 sk[4], sv[4];
#define NA_LOAD(T) do { const int _t = (T); const int _kt0 = _t < nloc ? b * SEQ + (rs + _t) * 64 : TL + b * CTX + (_t - nloc) * 64;                         \
        _Pragma("unroll") for (int q = 0; q < 4; ++q) { const int id = tid + 512 * q, row = id >> 5, ch = id & 31;                                                 \
            sk[q] = *(const bf16x8*)(PR + (size_t)(_kt0 + row) * INP + C_NAK + hg * 256 + ch * 8);                                                                \
            sv[q] = *(const bf16x8*)(PR + (size_t)(_kt0 + row) * INP + C_NAV + hg * 256 + ch * 8); } } while (0)
    NA_LOAD(0);
    for (int t = 0; t < NT; ++t) {
        __syncthreads();
#pragma unroll
        for (int q = 0; q < 4; ++q) { const int id = tid + 512 * q, row = id >> 5, ch = id & 31;
            *(bf16x8*)(Ks + at::kaddr<2>(row, ch)) = sk[q];
            *(bf16x8*)(Vs + (ch >> 4) * 16384 + at::v_st(row, (ch & 15) * 8)) = sv[q]; }
        __syncthreads();
        if (t + 1 < NT) NA_LOAD(t + 1);
        f32x16 p0, p1;
        at::qkt<4, 2>(p0, p1, Ks, qr, r32, hi, hh * 8);
        if (t < nloc) {
            const int c = qh * 32 + r32, cs = min(max(c - 8, 0), 48); const float* bt = bias + (hh * 8 + t) * 32;
#pragma unroll
            for (int rr = 0; rr < 16; ++rr) {
                const int k0 = at::crow(rr, hi), k1 = 32 + k0, d0 = k0 - c + 15, d1 = k1 - c + 15;
                const float b0 = bt[min(max(d0, 0), 31)], b1 = bt[min(max(d1, 0), 31)];
                p0[rr] = (k0 >= cs && k0 < cs + 16) ? fmaf(p0[rr], C, b0) : -1e30f;
                p1[rr] = (k1 >= cs && k1 < cs + 16) ? fmaf(p1[rr], C, b1) : -1e30f;
            }
        } else {
#pragma unroll
            for (int rr = 0; rr < 16; ++rr) { p0[rr] *= C; p1[rr] *= C; }
        }
        float pmax = p0[0];
#pragma unroll
        for (int rr = 1; rr < 16; ++rr) pmax = fmaxf(pmax, p0[rr]);
#pragma unroll
        for (int rr = 0; rr < 16; ++rr) pmax = fmaxf(pmax, p1[rr]);
        pmax = fmaxf(pmax, xshf<32>(pmax));
        const float mn = fmaxf(m_reg, pmax), al = __builtin_amdgcn_exp2f(m_reg - mn); m_reg = mn;
        float ps = 0.f;
#pragma unroll
        for (int rr = 0; rr < 16; ++rr) { p0[rr] = __builtin_amdgcn_exp2f(p0[rr] - mn); p1[rr] = __builtin_amdgcn_exp2f(p1[rr] - mn); ps += p0[rr] + p1[rr]; }
        ps += xshf<32>(ps);
        l_reg = l_reg * al + ps;
        if (hi == 0) al_l[r32] = al; asm volatile("s_waitcnt lgkmcnt(0)" ::: "memory");
#pragma unroll
        for (int d = 0; d < 2; ++d)
#pragma unroll
            for (int rr = 0; rr < 16; ++rr) o[d][rr] *= al_l[at::crow(rr, hi)];
        bf16x8 pa0, pa1, pa2, pa3; pack_p(p0, p1, pa0, pa1, pa2, pa3);
        at::pv_one<0>(o[0], vb, pa0, pa1, pa2, pa3); at::pv_one<1>(o[1], vb, pa0, pa1, pa2, pa3);
    }
#undef NA_LOAD
    if (hi == 0) li_l[r32] = l_reg; asm volatile("s_waitcnt lgkmcnt(0)" ::: "memory");
    bf16_t* Y = wsb(p, OFF_Y) + (size_t)(qtok + qh * 32) * DM + 1024 + (hg * 4 + hh) * 64;
#pragma unroll
    for (int rr = 0; rr < 16; ++rr) { const float rl = __builtin_amdgcn_rcpf(li_l[at::crow(rr, hi)]);
#pragma unroll
        for (int d = 0; d < 2; ++d) Y[(size_t)at::crow(rr, hi) * DM + d * 32 + r32] = f2bf(o[d][rr] * rl); }
    __syncthreads();
}

DEV int rt_tok0(int b, int n) { return n < 2 ? TL + b * CTX + n * 128 : b * SEQ + (n - 2) * 128; }
DEV int rt_sidx(int b, int h, int dir, int n) { const int sp = dir == 0 ? n : (n < 2 ? 1 - n : 19 - n); return (((b * 4 + h) * 2 + dir) * 18 + sp); }
DEV void rts_unit(const P& p, int l, int b, int h, int n, char* smem) {
    const int tid = lid();
    const int wid = tid >> 6, lane = tid & 63, r32 = lane & 31, hi = lane >> 5;
    const bf16_t* PR = wsb(p, OFF_PROJ); const int tok0 = rt_tok0(b, n);
    const float l2gf = wsf(p, OFF_MISC)[8 + (l * 2 + 0) * 4 + h], l2gb = wsf(p, OFF_MISC)[8 + (l * 2 + 1) * 4 + h];
    bf16_t* KtF = (bf16_t*)smem; bf16_t* KtB = KtF + 128 * 136; bf16_t* Vt = KtB + 128 * 136;
    __syncthreads();
#pragma unroll
    for (int q = 0; q < 4; ++q) { const int id = tid + 512 * q, j = id & 127, ch = id >> 7;
        const u32x4 kw = *(const u32x4*)(PR + (size_t)(tok0 + j) * INP + C_RTK + h * 128 + ch * 8);
        const u32x4 vw = *(const u32x4*)(PR + (size_t)(tok0 + j) * INP + C_RTV + h * 128 + ch * 8);
        const float zf = __builtin_amdgcn_exp2f(l2gf * (float)(127 - j)), zb = __builtin_amdgcn_exp2f(l2gb * (float)j);
        const unsigned kk[4] = {kw.x, kw.y, kw.z, kw.w}, vv[4] = {vw.x, vw.y, vw.z, vw.w};
#pragma unroll
        for (int e = 0; e < 4; ++e) { const float k0 = bflo(kk[e]), k1 = bfhi(kk[e]);
            KtF[(ch * 8 + e * 2) * 136 + j] = f2bf(k0 * zf); KtF[(ch * 8 + e * 2 + 1) * 136 + j] = f2bf(k1 * zf);
            KtB[(ch * 8 + e * 2) * 136 + j] = f2bf(k0 * zb); KtB[(ch * 8 + e * 2 + 1) * 136 + j] = f2bf(k1 * zb);
            Vt[(ch * 8 + e * 2) * 136 + j] = (bf16_t)(vv[e] & 0xffffu); Vt[(ch * 8 + e * 2 + 1) * 136 + j] = (bf16_t)(vv[e] >> 16); }
    }
    __syncthreads();
    const int eb = wid & 3, db0 = (wid >> 2) * 2;
    f32x16 aF[2] = {}, aB[2] = {};
#pragma unroll
    for (int ks = 0; ks < 8; ++ks) {
        const bf16x8 a = *(const bf16x8*)(Vt + (eb * 32 + r32) * 136 + ks * 16 + hi * 8);
#pragma unroll
        for (int dd = 0; dd < 2; ++dd) {
            const bf16x8 bF = *(const bf16x8*)(KtF + ((db0 + dd) * 32 + r32) * 136 + ks * 16 + hi * 8);
            const bf16x8 bB = *(const bf16x8*)(KtB + ((db0 + dd) * 32 + r32) * 136 + ks * 16 + hi * 8);
            aF[dd] = __builtin_amdgcn_mfma_f32_32x32x16_bf16(a, bF, aF[dd], 0, 0, 0);
            aB[dd] = __builtin_amdgcn_mfma_f32_32x32x16_bf16(a, bB, aB[dd], 0, 0, 0);
        }
    }
    float* SF = wsf(p, OFF_ST) + (size_t)rt_sidx(b, h, 0, n) * 16384; float* SB = wsf(p, OFF_ST) + (size_t)rt_sidx(b, h, 1, n) * 16384;
#pragma unroll
    for (int dd = 0; dd < 2; ++dd)
#pragma unroll
        for (int rr = 0; rr < 16; ++rr) { const int e = eb * 32 + at::crow(rr, hi), d = (db0 + dd) * 32 + r32; SF[e * 128 + d] = aF[dd][rr]; SB[e * 128 + d] = aB[dd][rr]; }
    __syncthreads();
}
DEV void phase_rtp(const P& p, int l, int bid, int nb) {
    const int tix = lid();
    for (int g = bid * 512 + tix; g < 64 * 4096; g += nb * 512) {
        const int seq = g >> 12, el = (g & 4095) * 4; const int dir = seq & 1, h = (seq >> 1) & 3;
        const float gC = __builtin_amdgcn_exp2f(wsf(p, OFF_MISC)[8 + (l * 2 + dir) * 4 + h] * 128.f);
        const float* S = wsf(p, OFF_ST) + (size_t)seq * 18 * 16384 + el; bf16_t* R = wsb(p, OFF_RT) + (size_t)seq * 18 * 16384 + el;
        float z0 = 0.f; asm volatile("" : "+v"(z0));
        f32x4 acc = {z0, z0, z0, z0};
        for (int sp = 0; sp < 18; ++sp) {
            u32x2 w; w.x = cvtpk(acc[0], acc[1]); w.y = cvtpk(acc[2], acc[3]); *(u32x2*)(R + (size_t)sp * 16384) = w;
            const f32x4 s = *(const f32x4*)(S + (size_t)sp * 16384); acc = acc * gC + s;
        }
    }
}
DEV void rto_unit(const P& p, int l, int b, int h, int n, char* smem) {
    const int tid = lid();
    const int wid = tid >> 6, lane = tid & 63, r32 = lane & 31, hi = lane >> 5;
    const bf16_t* PR = wsb(p, OFF_PROJ); const int tok0 = rt_tok0(b, n);
    const float l2gf = wsf(p, OFF_MISC)[8 + (l * 2 + 0) * 4 + h], l2gb = wsf(p, OFF_MISC)[8 + (l * 2 + 1) * 4 + h];
    bf16_t* Qs = (bf16_t*)smem; bf16_t* Ks = Qs + 128 * 136; bf16_t* Vt = Ks + 128 * 136; float* Os = (float*)smem;
    __syncthreads();
#pragma unroll
    for (int q = 0; q < 4; ++q) {
        { const int id = tid + 512 * q, j = id >> 4, ch = id & 15;
          *(u32x4*)(Qs + j * 136 + ch * 8) = *(const u32x4*)(PR + (size_t)(tok0 + j) * INP + C_RTQ + h * 128 + ch * 8);
          *(u32x4*)(Ks + j * 136 + ch * 8) = *(const u32x4*)(PR + (size_t)(tok0 + j) * INP + C_RTK + h * 128 + ch * 8); }
        { const int id = tid + 512 * q, j = id & 127, ch = id >> 7;
          const u32x4 vw = *(const u32x4*)(PR + (size_t)(tok0 + j) * INP + C_RTV + h * 128 + ch * 8);
          const unsigned vv[4] = {vw.x, vw.y, vw.z, vw.w};
#pragma unroll
          for (int e = 0; e < 4; ++e) { Vt[(ch * 8 + e * 2) * 136 + j] = (bf16_t)(vv[e] & 0xffffu); Vt[(ch * 8 + e * 2 + 1) * 136 + j] = (bf16_t)(vv[e] >> 16); } }
    }
    __syncthreads();
    const int nb_ = wid & 3, ebh = wid >> 2, nl = nb_ * 32 + r32;
    bf16x8 bq[8];
#pragma unroll
    for (int ks = 0; ks < 8; ++ks) bq[ks] = *(const bf16x8*)(Qs + (nb_ * 32 + r32) * 136 + ks * 16 + hi * 8);
    bf16x8 pb[8];
#pragma unroll
    for (int mb = 0; mb < 4; ++mb) {
        f32x16 s = {};
#pragma unroll
        for (int ks = 0; ks < 8; ++ks) { const bf16x8 a = *(const bf16x8*)(Ks + (mb * 32 + r32) * 136 + ks * 16 + hi * 8); s = __builtin_amdgcn_mfma_f32_32x32x16_bf16(a, bq[ks], s, 0, 0, 0); }
#pragma unroll
        for (int rr = 0; rr < 16; ++rr) { const int dlt = nl - (mb * 32 + at::crow(rr, hi));
            const float f = dlt > 0 ? __builtin_amdgcn_exp2f(l2gf * (float)dlt) : (dlt < 0 ? __builtin_amdgcn_exp2f(l2gb * (float)(-dlt)) : 2.f); s[rr] *= f; }
        u32x4 w0 = {cvtpk(s[0], s[1]), cvtpk(s[2], s[3]), cvtpk(s[4], s[5]), cvtpk(s[6], s[7])};
        u32x4 w1 = {cvtpk(s[8], s[9]), cvtpk(s[10], s[11]), cvtpk(s[12], s[13]), cvtpk(s[14], s[15])};
        pb[mb * 2] = *reinterpret_cast<bf16x8*>(&w0); pb[mb * 2 + 1] = *reinterpret_cast<bf16x8*>(&w1);
    }
    const bf16_t* RF = wsb(p, OFF_RT) + (size_t)rt_sidx(b, h, 0, n) * 16384; const bf16_t* RB = wsb(p, OFF_RT) + (size_t)rt_sidx(b, h, 1, n) * 16384;
    const float xif = __builtin_amdgcn_exp2f(l2gf * (float)(nl + 1)), xib = __builtin_amdgcn_exp2f(l2gb * (float)(128 - nl));
    f32x16 out[2];
#pragma unroll
    for (int dd = 0; dd < 2; ++dd) {
        const int e0 = (ebh * 2 + dd) * 32;
        f32x16 in_ = {}, cf = {}, cb = {};
#pragma unroll
        for (int kk = 0; kk < 8; ++kk) {
            const s16x4 lo = *(const s16x4*)(Vt + (e0 + r32) * 136 + kk * 16 + 4 * hi), hi4 = *(const s16x4*)(Vt + (e0 + r32) * 136 + kk * 16 + 8 + 4 * hi);
            const bf16x8 a = {lo[0], lo[1], lo[2], lo[3], hi4[0], hi4[1], hi4[2], hi4[3]};
            in_ = __builtin_amdgcn_mfma_f32_32x32x16_bf16(a, pb[kk], in_, 0, 0, 0);
        }
#pragma unroll
        for (int ks = 0; ks < 8; ++ks) {
            const bf16x8 af = *(const bf16x8*)(RF + (e0 + r32) * 128 + ks * 16 + hi * 8), ab = *(const bf16x8*)(RB + (e0 + r32) * 128 + ks * 16 + hi * 8);
            cf = __builtin_amdgcn_mfma_f32_32x32x16_bf16(af, bq[ks], cf, 0, 0, 0);
            cb = __builtin_amdgcn_mfma_f32_32x32x16_bf16(ab, bq[ks], cb, 0, 0, 0);
        }
#pragma unroll
        for (int rr = 0; rr < 16; ++rr) out[dd][rr] = in_[rr] + xif * cf[rr] + xib * cb[rr];
    }
    __syncthreads();
#pragma unroll
    for (int dd = 0; dd < 2; ++dd)
#pragma unroll
        for (int rr = 0; rr < 16; ++rr) Os[nl * 129 + (ebh * 2 + dd) * 32 + at::crow(rr, hi)] = out[dd][rr];
    __syncthreads();
    {
        const int nr = tid >> 2, part = tid & 3;
        float v[32]; float ss = 0.f;
#pragma unroll
        for (int i = 0; i < 32; ++i) { v[i] = Os[nr * 129 + part * 32 + i]; ss += v[i] * v[i]; }
        ss += xshf<1>(ss); ss += xshf<2>(ss);
        const float rs = rsqrtf(ss * (1.f / 128.f) + EPS);
        const float* ng = p.ret_norm_g + l * 128 + part * 32;
        const bf16_t* gp = PR + (size_t)(tok0 + nr) * INP + C_RTG + h * 128 + part * 32;
        bf16_t* yp = wsb(p, OFF_Y) + (size_t)(tok0 + nr) * DM + 512 + h * 128 + part * 32;
#pragma unroll
        for (int c = 0; c < 4; ++c) {
            const u32x4 gw = *(const u32x4*)(gp + c * 8); const unsigned gg[4] = {gw.x, gw.y, gw.z, gw.w};
            float y[8];
#pragma unroll
            for (int e = 0; e < 4; ++e) { y[e * 2] = v[c * 8 + e * 2] * rs * ng[c * 8 + e * 2] * siluf_(bflo(gg[e])); y[e * 2 + 1] = v[c * 8 + e * 2 + 1] * rs * ng[c * 8 + e * 2 + 1] * siluf_(bfhi(gg[e])); }
            u32x4 w = {cvtpk(y[0], y[1]), cvtpk(y[2], y[3]), cvtpk(y[4], y[5]), cvtpk(y[6], y[7])};
            *(u32x4*)(yp + c * 8) = w;
        }
    }
    __syncthreads();
}

DEV void peer_scores_phase(const P& p, int l, int nunits, int bid, int nb) {
    const int tid = lid();
    const int wid = tid >> 6, lane = tid & 63, r32 = lane & 31, hi = lane >> 5;
    int u = bid; if (u >= nunits) return;
    bf16x8 bq[8], bqn[8];
    { const bf16_t* q = wsb(p, OFF_QP) + (size_t)((u >> 4) * 256 + wid * 32 + r32) * DM + (u & 15) * 128 + hi * 8;
#pragma unroll
      for (int ks = 0; ks < 8; ++ks) bq[ks] = *(const bf16x8*)(q + ks * 16); }
#pragma unroll 1
    for (; u < nunits; u += nb) {
        const int tile = u >> 4, hs = u & 15, tok = tile * 256 + wid * 32 + r32, un = u + nb;
        if (un < nunits) { const bf16_t* q = wsb(p, OFF_QP) + (size_t)((un >> 4) * 256 + wid * 32 + r32) * DM + (un & 15) * 128 + hi * 8;
#pragma unroll
            for (int ks = 0; ks < 8; ++ks) bqn[ks] = *(const bf16x8*)(q + ks * 16); }
        const bf16_t* sk = wl(p, l, W_SK) + (size_t)hs * 16384 + hi * 8;
        float* SC = wsf(p, OFF_SC) + (size_t)hs * 128 * TA + tok;
#pragma unroll
        for (int kb = 0; kb < 4; ++kb) {
            f32x16 acc = {};
#pragma unroll
            for (int ks = 0; ks < 8; ++ks) { const bf16x8 a = *(const bf16x8*)(sk + (size_t)(kb * 32 + r32) * 128 + ks * 16); acc = __builtin_amdgcn_mfma_f32_32x32x16_bf16(a, bq[ks], acc, 0, 0, 0); }
#pragma unroll
            for (int rr = 0; rr < 16; ++rr) SC[(size_t)(kb * 32 + at::crow(rr, hi)) * TA] = acc[rr];
        }
#pragma unroll
        for (int ks = 0; ks < 8; ++ks) bq[ks] = bqn[ks];
    }
}
DEV unsigned mono(float v) { const unsigned u = __float_as_uint(v); return (u & 0x80000000u) ? ~u : (u | 0x80000000u); }
DEV float unmono(unsigned m) { return __uint_as_float((m & 0x80000000u) ? (m ^ 0x80000000u) : ~m); }
#define INS16(L, key) do { unsigned _k = (key); _Pragma("unroll") for (int _q = 0; _q < 16; ++_q) { const unsigned _h = max(L[_q], _k); _k = min(L[_q], _k); L[_q] = _h; } } while (0)
#define CE_DESC(a, b) do { const unsigned _h = max(a, b); b = min(a, b); a = _h; } while (0)
DEV void bitonic_sort_desc16(unsigned (&a)[16]) {
#pragma unroll
    for (int k = 2; k <= 16; k <<= 1)
#pragma unroll
        for (int j = k >> 1; j > 0; j >>= 1)
#pragma unroll
            for (int i = 0; i < 16; ++i) { const int l_ = i ^ j; if (l_ > i) { if ((i & k) == 0) CE_DESC(a[i], a[l_]); else CE_DESC(a[l_], a[i]); } }
}
DEV void bitonic_merge_desc16(unsigned (&a)[16]) {
#pragma unroll
    for (int j = 8; j > 0; j >>= 1)
#pragma unroll
        for (int i = 0; i < 16; ++i) { const int l_ = i ^ j; if (l_ > i) CE_DESC(a[i], a[l_]); }
}
DEV void top16_fold_sorted(unsigned (&L)[16], const unsigned (&N)[16]) {
#pragma unroll
    for (int q = 0; q < 16; ++q) L[q] = max(L[q], N[15 - q]);
    bitonic_merge_desc16(L);
}
DEV void peer_topk_task(const P& p, int h, int tok0, char* smem) {
    const int tid = lid();
    const int wid = tid >> 6, lane = tid & 63, tok = tok0 + lane;
    unsigned* lst = (unsigned*)smem + wid * 2048;
    const float* s0 = wsf(p, OFF_SC) + ((size_t)(h * (TA / 64) + (tok0 >> 6)) * 256) * 64 + lane; const float* s1 = s0 + 128 * 64;
    unsigned La[16], Lb[16];
#pragma unroll 1
    for (int i = 0; i < 128; i += 16) {
        float va[16], vb[16];
#pragma unroll
        for (int q = 0; q < 16; ++q) { va[q] = s0[(i + q) * 64]; vb[q] = s1[(i + q) * 64]; }
        unsigned Na[16], Nb[16];
#pragma unroll
        for (int q = 0; q < 16; ++q) { Na[q] = (mono(va[q]) & ~127u) | (unsigned)(127 - (i + q)); Nb[q] = (mono(vb[q]) & ~127u) | (unsigned)(127 - (i + q)); }
        bitonic_sort_desc16(Na); bitonic_sort_desc16(Nb);
        if (i == 0) {
#pragma unroll
            for (int q = 0; q < 16; ++q) { La[q] = Na[q]; Lb[q] = Nb[q]; }
        } else { top16_fold_sorted(La, Na); top16_fold_sorted(Lb, Nb); }
    }
#pragma unroll
    for (int q = 0; q < 16; ++q) { lst[q * 64 + lane] = La[q]; lst[(16 + q) * 64 + lane] = Lb[q]; }
    float fa[16], fb[16];
#pragma unroll
    for (int q = 0; q < 16; ++q) { fa[q] = unmono(La[q] & ~127u); fb[q] = unmono(Lb[q] & ~127u); }
#define CANDK(i, j) ((mono(fa[i] + fb[j]) & ~255u) | (unsigned)(255 - ((i) * 16 + (j))))
    unsigned L2[16];
#pragma unroll
    for (int q = 0; q < 16; ++q) L2[q] = CANDK(0, q);
    {   unsigned N[16];
#pragma unroll
        for (int q = 0; q < 15; ++q) N[q] = CANDK(q + 1, 0);
        N[15] = 0u;
        top16_fold_sorted(L2, N);
    }
    {
        constexpr int RI[19] = {1, 1, 1, 1, 1, 1, 1, 2, 2, 2, 2, 3, 3, 3, 4, 4, 5, 6, 7}, RJ[19] = {1, 2, 3, 4, 5, 6, 7, 1, 2, 3, 4, 1, 2, 3, 1, 2, 1, 1, 1};
        unsigned N[16];
#pragma unroll
        for (int q = 0; q < 16; ++q) N[q] = CANDK(RI[q], RJ[q]);
        bitonic_sort_desc16(N);
        top16_fold_sorted(L2, N);
#pragma unroll
        for (int q = 16; q < 19; ++q) INS16(L2, CANDK(RI[q], RJ[q]));
    }
#undef CANDK
    asm volatile("s_waitcnt lgkmcnt(0)" ::: "memory");
    float ev[16]; int ex[16]; float sum = 0.f; const float mx = unmono(L2[0] & ~255u);
#pragma unroll
    for (int k = 0; k < 16; ++k) {
        const int pos = 255 - (int)(L2[k] & 255u), i = pos >> 4, j = pos & 15;
        const unsigned ka = lst[i * 64 + lane], kb = lst[(16 + j) * 64 + lane];
        ex[k] = (127 - (int)(ka & 127u)) * 128 + (127 - (int)(kb & 127u));
        ev[k] = __expf(unmono(L2[k] & ~255u) - mx); sum += ev[k];
    }
    const float inv = 1.f / sum;
    unsigned short* pi = (unsigned short*)(p.ws + OFF_PIDX) + (size_t)tok * 128; float* pw = wsf(p, OFF_PW) + (size_t)tok * 128;
#pragma unroll
    for (int k = 0; k < 8; ++k) { const int slot = k * 16 + h * 2;
        *(unsigned*)(pi + slot) = (unsigned)ex[k] | ((unsigned)ex[k + 8] << 16); *(f32x2*)(pw + slot) = (f32x2){ev[k] * inv, ev[k + 8] * inv}; }
}
DEV float dot16(const u32x4 w, const float* h) {
    float s = 0.f;
#pragma unroll
    for (int k = 0; k < 4; ++k) { const f32x2 a = __builtin_amdgcn_cvt_pk_f32_fp8((int)w[k], false), b = __builtin_amdgcn_cvt_pk_f32_fp8((int)w[k], true);
        s += a[0] * h[4 * k] + a[1] * h[4 * k + 1] + b[0] * h[4 * k + 2] + b[1] * h[4 * k + 3]; }
    return s;
}
DEV void peer_gather_token(const P& p, int l, int tok, float* xl, float* xc, int lane, bool commit = true) {
    const unsigned char* U = (const unsigned char*)wl(p, l, W_U); const unsigned char* V = (const unsigned char*)wl(p, l, W_V);
    const float* US = (const float*)wl(p, l, W_US); const float* VS = (const float*)wl(p, l, W_VS);
    float hq[32];
    { const bf16_t* hrow = wsb(p, OFF_H) + (size_t)tok * DM + lane * 16;
#pragma unroll
      for (int c = 0; c < 2; ++c) { const u32x4 a = *(const u32x4*)(hrow + c * 1024), b = *(const u32x4*)(hrow + c * 1024 + 8);
          hq[c * 16 + 0] = bflo(a.x); hq[c * 16 + 1] = bfhi(a.x); hq[c * 16 + 2] = bflo(a.y); hq[c * 16 + 3] = bfhi(a.y); hq[c * 16 + 4] = bflo(a.z); hq[c * 16 + 5] = bfhi(a.z); hq[c * 16 + 6] = bflo(a.w); hq[c * 16 + 7] = bfhi(a.w);
          hq[c * 16 + 8] = bflo(b.x); hq[c * 16 + 9] = bfhi(b.x); hq[c * 16 + 10] = bflo(b.y); hq[c * 16 + 11] = bfhi(b.y); hq[c * 16 + 12] = bflo(b.z); hq[c * 16 + 13] = bfhi(b.z); hq[c * 16 + 14] = bflo(b.w); hq[c * 16 + 15] = bfhi(b.w); } }
    const int* pi = (const int*)(p.ws + OFF_PIDX) + (size_t)tok * 128; const float* pw = wsf(p, OFF_PW) + (size_t)tok * 128;
    const int i0 = pi[lane], i1 = pi[64 + lane];
    const float us0 = US[i0], us1 = US[i1];
    const float gv0 = pw[lane] * VS[i0], gv1 = pw[64 + lane] * VS[i1];
    float w0 = 0.f, w1 = 0.f;
    for (int eb = 0; eb < 16; ++eb) {
        u32x4 ur[8][2];
#pragma unroll
        for (int q = 0; q < 8; ++q) { const int e = eb * 8 + q; const int idx = __builtin_amdgcn_readlane(e < 64 ? i0 : i1, e & 63);
            const unsigned char* ur_ = U + (size_t)idx * DM;
#pragma unroll
            for (int c = 0; c < 2; ++c) ur[q][c] = *(const u32x4*)(ur_ + (unsigned)(lane * 16 + c * 1024)); }
#pragma unroll
        for (int q = 0; q < 8; ++q) { const int e = eb * 8 + q;
            float d = dot16(ur[q][0], hq) + dot16(ur[q][1], hq + 16);
            d = wave_sum(d) * (e < 64 ? us0 : us1);
            const float a = 0.5f * d * (1.f + erff(d * 0.70710678118654752f));
            if ((e & 63) == lane) { if (e < 64) w0 = a * gv0; else w1 = a * gv1; }
            __builtin_amdgcn_sched_barrier(0); }
    }
    float acc[32];
#pragma unroll
    for (int i = 0; i < 32; ++i) acc[i] = 0.f;
    for (int eb = 0; eb < 16; ++eb) {
        u32x4 vr[8][2]; float wv[8];
#pragma unroll
        for (int q = 0; q < 8; ++q) { const int e = eb * 8 + q; const int idx = __builtin_amdgcn_readlane(e < 64 ? i0 : i1, e & 63);
            wv[q] = __uint_as_float((unsigned)__builtin_amdgcn_readlane((int)__float_as_uint(e < 64 ? w0 : w1), e & 63));
            const unsigned char* vr_ = V + (size_t)idx * DM;
#pragma unroll
            for (int c = 0; c < 2; ++c) vr[q][c] = *(const u32x4*)(vr_ + (unsigned)(lane * 16 + c * 1024)); }
#pragma unroll
        for (int q = 0; q < 8; ++q) {
#pragma unroll
            for (int c = 0; c < 2; ++c)
#pragma unroll
                for (int k = 0; k < 4; ++k) { const f32x2 a = __builtin_amdgcn_cvt_pk_f32_fp8((int)vr[q][c][k], false), b = __builtin_amdgcn_cvt_pk_f32_fp8((int)vr[q][c][k], true); const float w = wv[q];
                    acc[c * 16 + 4 * k] += w * a[0]; acc[c * 16 + 4 * k + 1] += w * a[1]; acc[c * 16 + 4 * k + 2] += w * b[0]; acc[c * 16 + 4 * k + 3] += w * b[1]; }
            asm volatile("" : "+v"(acc[0]), "+v"(acc[1]), "+v"(acc[2]), "+v"(acc[3]), "+v"(acc[4]), "+v"(acc[5]), "+v"(acc[6]), "+v"(acc[7]), "+v"(acc[8]), "+v"(acc[9]), "+v"(acc[10]), "+v"(acc[11]), "+v"(acc[12]), "+v"(acc[13]), "+v"(acc[14]), "+v"(acc[15]));
            asm volatile("" : "+v"(acc[16]), "+v"(acc[17]), "+v"(acc[18]), "+v"(acc[19]), "+v"(acc[20]), "+v"(acc[21]), "+v"(acc[22]), "+v"(acc[23]), "+v"(acc[24]), "+v"(acc[25]), "+v"(acc[26]), "+v"(acc[27]), "+v"(acc[28]), "+v"(acc[29]), "+v"(acc[30]), "+v"(acc[31])); }
    }
    const int r = tok < TL ? (tok >> 11) : 8;
    float* xr = tok < TL ? xl + (size_t)tok * DM : xc + (size_t)(tok - TL) * DM;
    const float* g2 = wsf(p, OFF_MOD) + ((size_t)l * 9 + r) * 12288 + 5 * DM;
#pragma unroll
    for (int c = 0; c < 2; ++c)
#pragma unroll
        for (int k = 0; k < 4; ++k) {
            const int i = c * 1024 + lane * 16 + k * 4;
            f32x4 xa = *(const f32x4*)(xr + i); const f32x4 ga = *(const f32x4*)(g2 + i);
#pragma unroll
            for (int q = 0; q < 4; ++q) xa[q] += ga[q] * acc[c * 16 + k * 4 + q];
            if (commit || xa[0] == 1.2345e30f) *(f32x4*)(xr + i) = xa;
        }
}

DEV void pl_ld_idx(const char* base, unsigned off, u32x4 (&ix)[2]) { ix[0] = *(const u32x4*)(base + off); ix[1] = *(const u32x4*)(base + off + 16u); }
DEV unsigned pl_idx(const u32x4 (&ix)[2], int k) { const unsigned w = ix[k >> 3][(k >> 1) & 3]; return (k & 1) ? (w >> 16) : (w & 0xffffu); }
DEV void pl_ld_rows(const unsigned char* T, unsigned so  , const u32x4 (&ix)[2], u32x4 (&r)[16]) {
#pragma unroll
    for (int k = 0; k < 16; ++k) r[k] = *(const u32x4*)(T + (pl_idx(ix, k) * 128u + so));
}
DEV int red8i(int v) { v += __builtin_amdgcn_update_dpp(0, v, 0xB1, 0xF, 0xF, true); v += __builtin_amdgcn_update_dpp(0, v, 0x4E, 0xF, 0xF, true); v += __builtin_amdgcn_update_dpp(0, v, 0x141, 0xF, 0xF, true); return v; }
DEV int dot16i(const u32x4 w, const u32x4 h) { int s = 0;
#pragma unroll
    for (int k = 0; k < 4; ++k) s = __builtin_amdgcn_sdot4((int)w[k], (int)h[k], s, false);
    return s; }
DEV void pu_compute(const u32x4 (&r)[16], const u32x4 h, char* ppb, unsigned poff, int c8, bool ok) {
    u32x2 o2 = {0u, 0u};
#pragma unroll
    for (int c = 0; c < 8; ++c) { const int da = red8i(dot16i(r[2 * c], h)), db = red8i(dot16i(r[2 * c + 1], h)); if (c8 == c) o2 = (u32x2){(unsigned)da, (unsigned)db}; }
    if (ok) *(u32x2*)(ppb + poff) = o2;
}
DEV void peer_u_pass(const P& p, int l, int MR, int bid, int nb) {
    const int tix = lid(); const int wid = tix >> 6, lane = tix & 63, c8 = lane & 7, pg = lane >> 3;
    const unsigned char* U = (const unsigned char*)wl(p, l, W_U);
    const char* PIL = p.ws + OFF_PIDX; const char* Hb = p.ws + OFF_H8;
    const int xg = bid & 7, rank = bid >> 3, nrank = (nb + 7 - xg) >> 3, stride = nrank * 8, tl = MR - 1;
    const unsigned ioff = (unsigned)(pg * 32);
#pragma unroll 1
    for (int sp = 0; sp < 2; ++sp) {
        const int s = xg + 8 * sp; const unsigned so = (unsigned)(s * (16384 * 128) + c8 * 16);
        char* PPs = p.ws + OFF_SC + (size_t)s * TA * 512;
        const unsigned hoff = (unsigned)(s * 128 + c8 * 16), pofl = (unsigned)(pg * 16 + 2 * c8) * 4u;
        int t = rank * 8 + wid;
        u32x4 ixA[2], ixB[2], rA[16], rB[16], hA, hB;
        { const unsigned tt = (unsigned)min(t, tl); pl_ld_idx(PIL, tt * 256u + ioff, ixA); pl_ld_rows(U, so, ixA, rA); hA = *(const u32x4*)(Hb + (tt * 2048u + hoff)); }
        pl_ld_idx(PIL, (unsigned)min(t + stride, tl) * 256u + ioff, ixB);
#pragma unroll 1
        for (; t < MR; t += 2 * stride) {
            { const unsigned tt = (unsigned)min(t + stride, tl); pl_ld_rows(U, so, ixB, rB); hB = *(const u32x4*)(Hb + (tt * 2048u + hoff)); }
            pl_ld_idx(PIL, (unsigned)min(t + 2 * stride, tl) * 256u + ioff, ixA);
            pu_compute(rA, hA, PPs, (unsigned)t * 512u + pofl, c8, true);
            { const unsigned tt = (unsigned)min(t + 2 * stride, tl); pl_ld_rows(U, so, ixA, rA); hA = *(const u32x4*)(Hb + (tt * 2048u + hoff)); }
            pl_ld_idx(PIL, (unsigned)min(t + 3 * stride, tl) * 256u + ioff, ixB);
            pu_compute(rB, hB, PPs, (unsigned)min(t + stride, tl) * 512u + pofl, c8, t + stride < MR);
        }
    }
}
DEV void peer_mid(const P& p, int l, int MR, int bid, int nb) {
    const int tix = lid();
    const float* US = (const float*)wl(p, l, W_US); const float* VS = (const float*)wl(p, l, W_VS);
    const float* HSC = (const float*)wl(p, l, W_SK);
    const int* PP = (const int*)(p.ws + OFF_SC); const unsigned short* PI = (const unsigned short*)(p.ws + OFF_PIDX); const float* PW = wsf(p, OFF_PW); bf16_t* PWL = (bf16_t*)(p.ws + OFF_ST);
    for (int g4 = bid * 512 + tix; g4 < MR * 32; g4 += nb * 512) {
        const size_t g = (size_t)g4 * 4;
        i32x4 di = {0, 0, 0, 0};
#pragma unroll
        for (int s_ = 0; s_ < 16; ++s_) di += *(const i32x4*)(PP + (size_t)s_ * TA * 128 + g);
        const float hs = HSC[g4 >> 5];
        const f32x4 d = {(float)di[0] * hs, (float)di[1] * hs, (float)di[2] * hs, (float)di[3] * hs};
        const u32x2 iw = *(const u32x2*)(PI + g); const f32x4 gw = *(const f32x4*)(PW + g);
        const unsigned id[4] = {iw.x & 0xffffu, iw.x >> 16, iw.y & 0xffffu, iw.y >> 16}; float wv[4];
#pragma unroll
        for (int q = 0; q < 4; ++q) { const float dd = d[q] * US[id[q]]; const float a = 0.5f * dd * (1.f + erff(dd * 0.70710678118654752f)); wv[q] = a * gw[q] * VS[id[q]]; }
        { float am = fmaxf(fmaxf(fabsf(wv[0]), fabsf(wv[1])), fmaxf(fabsf(wv[2]), fabsf(wv[3])));
          am = fmaxf(am, xshf<1>(am)); am = fmaxf(am, xshf<2>(am)); am = fmaxf(am, xshf<4>(am)); am = fmaxf(am, xshf<8>(am)); am = fmaxf(am, xshf<16>(am));
          const float sc = am > 0.f ? 6.f / am : 1.f;
          const float a0 = wv[0] * sc, a1 = wv[1] * sc, a2 = wv[2] * sc, a3 = wv[3] * sc;
          unsigned q1 = 0u; q1 = __builtin_amdgcn_cvt_scalef32_pk_fp4_f32(q1, a0, a1, 1.0f, 0); q1 = __builtin_amdgcn_cvt_scalef32_pk_fp4_f32(q1, a2, a3, 1.0f, 1);
          const f32x2 d01 = __builtin_amdgcn_cvt_scalef32_pk_f32_fp4(q1, 1.0f, 0), d23 = __builtin_amdgcn_cvt_scalef32_pk_f32_fp4(q1, 1.0f, 1);
          unsigned q2 = 0u; q2 = __builtin_amdgcn_cvt_scalef32_pk_fp4_f32(q2, (a0 - d01[0]) * 4.f, (a1 - d01[1]) * 4.f, 1.0f, 0); q2 = __builtin_amdgcn_cvt_scalef32_pk_fp4_f32(q2, (a2 - d23[0]) * 4.f, (a3 - d23[1]) * 4.f, 1.0f, 1);
          unsigned char* pw4 = (unsigned char*)PWL + (size_t)(g4 >> 5) * 128 + ((g & 127) >> 1);
          *(unsigned short*)pw4 = (unsigned short)q1; *(unsigned short*)(pw4 + 64) = (unsigned short)q2;
          if ((tix & 31) == 0) ((float*)((unsigned char*)PWL + (size_t)TA * 128))[g4 >> 5] = am > 0.f ? am * (1.f / 6.f) : 1.f; }
    }
}
DEV float swsum32(float a, float b) { auto r = __builtin_amdgcn_permlane32_swap(__float_as_uint(a), __float_as_uint(b), false, false); return __uint_as_float(r[0]) + __uint_as_float(r[1]); }
DEV float swsum16(float a, float b) { auto r = __builtin_amdgcn_permlane16_swap(__float_as_uint(a), __float_as_uint(b), false, false); return __uint_as_float(r[0]) + __uint_as_float(r[1]); }
typedef int v2i_t __attribute__((ext_vector_type(2)));
DEV void peer_v_pass(const P& p, int l, int MR, bf16_t* xb, float* outf, int bid, int nb, bool commit, char* smem) {
    const int tix = lid(); const int wid = tix >> 6, lane = tix & 63, c8 = lane & 7, pg = lane >> 3, n = lane & 15, kg = lane >> 4;
    const unsigned char* V = (const unsigned char*)wl(p, l, W_V);
    const char* PIL = p.ws + OFF_PIDX; const char* PW8 = p.ws + OFF_ST; const float* WSC = (const float*)(p.ws + OFF_ST + (size_t)TA * 128);
    const int xg = bid & 7, rank = bid >> 3, nrank = (nb + 7 - xg) >> 3, stride = nrank * 8, tl = MR - 1;
    typedef g8::v8i v8i;
    const int s = xg; const unsigned so = (unsigned)(s * (16384 * 128) + c8 * 16);
    const unsigned ioff = (unsigned)(pg * 32);
    LAS unsigned char* LW = (LAS unsigned char*)smem + wid * 16384;
    const unsigned wbase = (unsigned)(pg * 2048), ca = (unsigned)(2 * c8), cb = (unsigned)(2 * c8 + 1);
    const unsigned rbase = (unsigned)((32 * kg + n) * 128);
#define PV_TT(d) ((unsigned)min(t + (d) * stride, tl))
    struct Small { u32x4 wa, wb; float wsc; u32x2 x; f32x4 g; };
#define PV_SMALL(S, TOK) do { const unsigned tk_ = (TOK); S.wa = *(const u32x4*)(PW8 + (tk_ * 128u + (unsigned)(kg * 16))); S.wb = *(const u32x4*)(PW8 + (tk_ * 128u + 64u + (unsigned)(kg * 16))); \
        S.wsc = WSC[tk_]; const int r_ = tk_ < (unsigned)TL ? (int)(tk_ >> 11) : 8; const unsigned co_ = (unsigned)(s * 256 + 64 * kg + 4 * n); \
        S.x = *(const u32x2*)(xb + ((size_t)tk_ * DM + co_)); S.g = *(const f32x4*)(wsf(p, OFF_MOD) + (((size_t)l * 9 + r_) * 12288 + 5 * DM + co_)); } while (0)
      \
#define PV_IMG(R) do { _Pragma("unroll") for (int k = 0; k < 16; ++k) { \
        if ((k & 1) == 0) *(LAS u32x4*)(LW + (wbase + (unsigned)(k * 128) + ((ca ^ (unsigned)k) << 3))) = R[k]; \
        else *(LAS u32x4*)(LW + (wbase + (unsigned)(k * 128) + ((cb ^ (unsigned)k) << 3))) = (u32x4){R[k].z, R[k].w, R[k].x, R[k].y}; } } while (0)
    int t = rank * 8 + wid;
    u32x4 ix2[2], ix3[2], rA[16], rB[16]; Small sC, sN;
    { u32x4 ix0[2], ix1[2]; pl_ld_idx(PIL, PV_TT(0) * 256u + ioff, ix0); pl_ld_idx(PIL, PV_TT(1) * 256u + ioff, ix1); pl_ld_idx(PIL, PV_TT(2) * 256u + ioff, ix2);
      PV_SMALL(sC, PV_TT(0));
      pl_ld_rows(V, so, ix0, rA); pl_ld_rows(V, so, ix1, rB); }
    auto compute = [&](const Small& S, int tok, bool ok) {
        const v8i A = {(int)S.wa.x, (int)S.wa.y, (int)S.wa.z, (int)S.wa.w, 0, 0, 0, 0}, A2 = {(int)S.wb.x, (int)S.wb.y, (int)S.wb.z, (int)S.wb.w, 0, 0, 0, 0};
        float val[4] = {0.f, 0.f, 0.f, 0.f};
#pragma unroll 1
        for (int jo = 0; jo < 4; ++jo)
#pragma unroll
        for (int jj = 0; jj < 4; ++jj) {
            const int j = jo * 4 + jj;
            LAS v2i_t* ra = (LAS v2i_t*)(LW + (rbase + (((unsigned)j ^ (unsigned)n) << 3)));
            const v2i_t lo = __builtin_amdgcn_ds_read_tr4_b64_v2i32(ra), hi2 = __builtin_amdgcn_ds_read_tr4_b64_v2i32((LAS v2i_t*)((LAS unsigned char*)ra + 2048));
            const v8i B = {lo.x, lo.y, hi2.x, hi2.y, 0, 0, 0, 0};
            const f32x4 z = {};
            const f32x4 d = __builtin_amdgcn_mfma_scale_f32_16x16x128_f8f6f4(A, B, z, 4, 4, 0, 0x7F7F7F7F, 0, 0x7F7F7F7F);
            const f32x4 d2 = __builtin_amdgcn_mfma_scale_f32_16x16x128_f8f6f4(A2, B, z, 4, 4, 0, 0x7F7F7F7F, 0, 0x7F7F7F7F);
            if (jo == kg) val[jj] = d[0] + 0.25f * d2[0];
        }
        LAS float* xs = (LAS float*)((LAS unsigned char*)smem + (131072 + 512) + wid * 1024);
#pragma unroll
        for (int jj = 0; jj < 4; ++jj) xs[64 * kg + 16 * jj + n] = val[jj];
        const f32x4 v4 = *(const LAS f32x4*)(xs + 64 * kg + 4 * n);
        if (ok) {
            const size_t eo = (size_t)tok * DM + s * 256 + 64 * kg + 4 * n;
            const float y0 = bflo(S.x.x) + S.g[0] * (v4[0] * S.wsc), y1 = bfhi(S.x.x) + S.g[1] * (v4[1] * S.wsc), y2 = bflo(S.x.y) + S.g[2] * (v4[2] * S.wsc), y3 = bfhi(S.x.y) + S.g[3] * (v4[3] * S.wsc);
            if (outf) *(f32x4*)(outf + eo) = (f32x4){y0, y1, y2, y3};
            else { u32x2 o; o.x = cvtpk(y0, y1); o.y = cvtpk(y2, y3); *(u32x2*)(xb + eo) = o; }
        }
    };
    __syncthreads();
#pragma unroll 1
    for (; t < MR; t += 2 * stride) {
        PV_IMG(rA);
        PV_SMALL(sN, PV_TT(1));
        pl_ld_rows(V, so, ix2, rA);
        pl_ld_idx(PIL, PV_TT(3) * 256u + ioff, ix3);
        compute(sC, t, commit);
        PV_IMG(rB);
        PV_SMALL(sC, PV_TT(2));
        pl_ld_rows(V, so, ix3, rB);
        pl_ld_idx(PIL, PV_TT(4) * 256u + ioff, ix2);
        compute(sN, (int)PV_TT(1), commit && (t + stride < MR));
    }
#undef PV_SMALL
#undef PV_IMG
#undef PV_TT
}

#define XB_TMO      128
#define XB_XCNT(j)  (256  + 64 * (j))
#define XB_XSUB(j)  (1280 + 64 * (j))
#define XB_XGEN(j)  (2304 + 64 * (j))
#define XB_TOP      3328
#define XB_TOPGEN   3392
#define XCD_BAR_WORDS 3456
#define XB_SPIN_CAP (1u << 20)
DEV unsigned xb_ld(unsigned* p)              { return __hip_atomic_load(p, __ATOMIC_RELAXED, __HIP_MEMORY_SCOPE_AGENT); }
DEV unsigned xb_add(unsigned* p, unsigned v) { return __hip_atomic_fetch_add(p, v, __ATOMIC_RELAXED, __HIP_MEMORY_SCOPE_AGENT); }
DEV unsigned xb_xcc_id() { return (unsigned)__builtin_amdgcn_s_getreg((3 << 11) | 20) & 0xFu; }
#define XB_SPIN(cond, bar) do { unsigned _sp = 0; while (cond) { __builtin_amdgcn_s_sleep(1); \
    if ((++_sp & 255u) == 0u) { if (xb_ld(&(bar)[XB_TMO])) break; if (_sp > XB_SPIN_CAP) { atomicAdd(&(bar)[XB_TMO], 1u); break; } } } } while (0)
struct XcdBarrier { unsigned* bar; unsigned x; volatile LAS unsigned* st; };
DEV XcdBarrier xcd_barrier_post(unsigned* bar, volatile LAS unsigned* st) {
    XcdBarrier b; b.bar = bar; b.x = xb_xcc_id(); b.st = st;
    if (lid() == 0) (void)xb_add(&bar[XB_XCNT(b.x)], 1u);
    return b;
}
DEV void xcd_barrier_complete(unsigned* bar, unsigned x, unsigned& nloc, unsigned& nx) {
    const unsigned G = gridDim.x * gridDim.y * gridDim.z;
    unsigned sum, cnt, mine, sp = 0u;
    for (;;) {
        sum = 0u; cnt = 0u; mine = 0u;
#pragma unroll
        for (unsigned j = 0; j < 16; ++j) { const unsigned c = xb_ld(&bar[XB_XCNT(j)]); sum += c; cnt += (c > 0u) ? 1u : 0u; mine = (j == x) ? c : mine; }
        if (sum == G) break;
        __builtin_amdgcn_s_sleep(1);
        if ((++sp & 255u) == 0u) { if (xb_ld(&bar[XB_TMO])) break; if (sp > XB_SPIN_CAP) { atomicAdd(&bar[XB_TMO], 1u); break; } }
    }
    nloc = mine > 0u ? mine : 1u; nx = cnt > 0u ? cnt : 1u;
}
DEV void xcd_barrier(const XcdBarrier& b) {
    asm volatile("s_waitcnt vmcnt(0)" ::: "memory");
    __syncthreads();
    if (lid() == 0) {
        unsigned* bar = b.bar;
        const unsigned bx = __builtin_amdgcn_readfirstlane(xb_xcc_id());
        __builtin_amdgcn_s_waitcnt(0);
        unsigned nloc = b.st[0], nx = b.st[1];
        if (nloc == 0u) { xcd_barrier_complete(bar, bx, nloc, nx); b.st[0] = nloc; b.st[1] = nx; }
        const unsigned old = xb_add(&bar[XB_XSUB(bx)], 1u);
        const unsigned gen = old / nloc;
        if (old + 1u == (gen + 1u) * nloc) {
            __builtin_amdgcn_fence(__ATOMIC_RELEASE, "agent");
            asm volatile("s_waitcnt vmcnt(0)" ::: "memory");
            const unsigned og = xb_add(&bar[XB_TOP], 1u);
            const unsigned tg = og / nx;
            if (og + 1u == (tg + 1u) * nx) xb_add(&bar[XB_TOPGEN], 1u);
            else XB_SPIN(xb_ld(&bar[XB_TOPGEN]) == tg, bar);
            __builtin_amdgcn_fence(__ATOMIC_ACQUIRE, "agent");
            xb_add(&bar[XB_XGEN(bx)], 1u);
            asm volatile("s_waitcnt vmcnt(0)" ::: "memory");
        } else {
            XB_SPIN(xb_ld(&bar[XB_XGEN(bx)]) == gen, bar);
            __builtin_amdgcn_fence(__ATOMIC_ACQUIRE, "agent");
            asm volatile("s_waitcnt vmcnt(0)" ::: "memory");
        }
    }
    __syncthreads();
}

enum { PH_PRO = 0, PH_NORM1, PH_PROJ, PH_PREP1, PH_UP, PH_PREP2, PH_MIX, PH_Z, PH_G, PH_O, PH_NORM2, PH_PQ, PH_PSC, PH_PTK, PH_PGA, PH_PU, PH_PM, PH_PV, PH_COUNT };

template <int PH>
DEV void run_phase(const P& p_, const int l, char* smem, const int bid, const int nb, const bool commit = true) {
    P p = p_;
#if defined(__HIP_DEVICE_COMPILE__)
    {   typedef __attribute__((address_space(4))) const P CP; typedef __attribute__((address_space(1))) char gch;
        CP* pp = (CP*)__builtin_amdgcn_kernarg_segment_ptr(); asm volatile("" : "+s"(pp)); (void)p_;
#define GLB(f) p.f = (decltype(p.f))(gch*)(pp->f)
        GLB(x); GLB(c); GLB(ctx); GLB(c_ctx); GLB(w_mod); GLB(b_mod); GLB(norm1_g); GLB(norm2_g); GLB(w_in); GLB(diff_lambda); GLB(diff_qk_g); GLB(diff_sub_g); GLB(ret_decay); GLB(ret_norm_g);
        GLB(na_qk_g); GLB(na_rpb); GLB(mla_q_norm_g); GLB(mla_kv_norm_g); GLB(w_uq); GLB(w_ukv); GLB(mla_qk_g); GLB(w_branch); GLB(w_gate); GLB(b_gate); GLB(w_o); GLB(peer_w_query); GLB(peer_sub_keys);
        GLB(peer_u); GLB(peer_v); GLB(out); GLB(ws);
#undef GLB
    }
#endif
    const bool last = (l == 1);
    int MR = last ? TL : TA;
    asm volatile("" : "+s"(MR));
    bf16_t* xb = wsb(p, OFF_XB);
    const float* mod = wsf(p, OFF_MOD) + (size_t)l * 9 * 12288;
    if constexpr (PH == PH_PRO) { phase_prologue(p, smem, bid, nb); }
    if constexpr (PH == PH_NORM1) {
        constexpr bool NEED_BF16 = !PROJ_FP8 || ((0xFFFFFFu & ~PROJ_F8_MASK) != 0u);
        phase_norm(p.x, p.ctx, p.norm1_g + l * DM, mod, 0, 1, NEED_BF16 ? wsb(p, OFF_H) : nullptr, TA, bid, nb, (unsigned char*)(p.ws + OFF_H8), nullptr, nullptr, l == 0 ? nullptr : xb); }
    if constexpr (PH == PH_PROJ) {
        constexpr unsigned M8 = PROJ_FP8 ? (PROJ_F8_MASK & 0xFFFFFFu) : 0u, M16 = 0xFFFFFFu & ~M8;
        if constexpr (M8 != 0u) { g8::EpiBf16 e{wsb(p, OFF_PROJ), INP, 0, commit, 1.f / 256.f};
            g8::gemm_stream_f8<DM, false>((const unsigned char*)(p.ws + OFF_H8), (const unsigned char*)wl(p, l, W_IN8), g8::Order{TA / 256, __builtin_popcount(M8), 1, nb, bid, M8, STAG_PROJ}, e, smem); }
        if constexpr (M16 != 0u) { g8::EpiBf16 e{wsb(p, OFF_PROJ), INP, 0, commit};
            g8::gemm_stream<DM, DM, true>(wsb(p, OFF_H), 0, wl(p, l, W_IN), 0, g8::Order{TA / 256, __builtin_popcount(M16), 1, nb, bid, M16}, e, smem); }
    }
    if constexpr (PH == PH_PREP1) { phase_prep1(p, l, bid, nb); }
    if constexpr (PH == PH_UP) {
        { g8::EpiBf16 e{wsb(p, OFF_QM), 768, 0}; g8::gemm_stream<INP, 512, true>(wsb(p, OFF_PROJ) + C_MCQ, 0, wl(p, l, W_UQ), 0, g8::Order{TA / 256, 3, 1, nb, bid}, e, smem); }
        { g8::EpiBf16 e{wsb(p, OFF_KVM), 1024, 0}; g8::gemm_stream<INP, 256, true>(wsb(p, OFF_PROJ) + C_MKV, 0, wl(p, l, W_UKV), 0, g8::Order{TA / 256, 4, 1, nb, bid}, e, smem); }
        for (int u = (bid + nb - 192 % nb) % nb; u < 576; u += nb) rts_unit(p, l, u & 7, (u >> 3) & 3, u >> 5, smem);
    }
    if constexpr (PH == PH_PREP2) { phase_prep2(p, l, bid, nb); phase_rtp(p, l, bid, nb); }
    if constexpr (PH == PH_MIX) {
#ifndef PROBE_MIX
#define PROBE_MIX -1
#endif
#pragma unroll 1
        for (int rp = 0; rp < (PROBE_MIX == 0 ? 2 : 1); ++rp)
        for (int u = bid; u < 256; u += nb) mla_unit(p, u & 7, (u >> 3) & 3, (u & 7) * SEQ + (u >> 5) * 256, false, smem);
#pragma unroll 1
        for (int rp = 0; rp < (PROBE_MIX == 1 ? 2 : 1); ++rp)
        for (int u = bid; u < 512; u += nb) da_unit(p, l, u & 7, (u >> 3) & 3, (u & 7) * SEQ + (u >> 5) * 128, false, smem);
#pragma unroll 1
        for (int rp = 0; rp < (PROBE_MIX == 2 ? 2 : 1); ++rp)
        for (int u = bid; u < 512; u += nb) na_unit(p, l, u & 7, (u >> 3) & 31, u >> 8, false, smem);
#pragma unroll 1
        for (int rp = 0; rp < (PROBE_MIX == 3 ? 2 : 1); ++rp)
        for (int u = bid; u < 512; u += nb) rto_unit(p, l, u & 7, (u >> 3) & 3, 2 + (u >> 5), smem);
        if (!last) {
            for (int u = bid; u < 32; u += nb) mla_unit(p, u & 7, (u >> 3) & 3, TL + (u & 7) * CTX, true, smem);
            for (int u = (bid + nb - 32 % nb) % nb; u < 64; u += nb) da_unit(p, l, u & 7, (u >> 3) & 3, TL + (u & 7) * CTX + (u >> 5) * 128, true, smem);
            for (int u = (bid + nb - 96 % nb) % nb; u < 64; u += nb) na_unit(p, l, u & 7, (u >> 3) & 3, u >> 5, true, smem);
            for (int u = (bid + nb - 160 % nb) % nb; u < 64; u += nb) rto_unit(p, l, u & 7, (u >> 3) & 3, u >> 5, smem);
        }
    }
    if constexpr (PH == PH_Z) {
        g8::EpiBf16 e{wsb(p, OFF_Z), 8192, 2048};
        g8::gemm_stream<DM, 512, true>(wsb(p, OFF_Y), 512, wl(p, l, W_B), (size_t)DM * 512, g8::Order{MR / 256, 8, 4, nb, bid, 0u, STAG_Z}, e, smem);
    }
    if constexpr (PH == PH_G) { g8::EpiMerge e{wsb(p, OFF_M), wsb(p, OFF_Z), p.b_gate + (size_t)l * 4 * DM, 1.f / 256.f}; g8::gemm_stream_f8<DM, false>((const unsigned char*)(p.ws + OFF_H8), (const unsigned char*)wl(p, l, W_G), g8::Order{MR / 256, 32, 1, nb, bid, 0u, STAG_G}, e, smem); }
    if constexpr (PH == PH_O) {
        if (l == 0) { g8::EpiResidB<false> e{p.x, p.ctx, xb, mod + 2 * DM}; g8::gemm_stream<DM, DM, true>(wsb(p, OFF_M), 0, wl(p, l, W_O), 0, g8::Order{MR / 256, 8, 1, nb, bid}, e, smem); }
        else { g8::EpiResidB<true> e{p.x, p.ctx, xb, mod + 2 * DM}; g8::gemm_stream<DM, DM, true>(wsb(p, OFF_M), 0, wl(p, l, W_O), 0, g8::Order{MR / 256, 8, 1, nb, bid}, e, smem); }
    }
    if constexpr (PH == PH_NORM2) { phase_norm(p.x, p.ctx, p.norm2_g + l * DM, mod, 3, 4, wsb(p, OFF_H), MR, bid, nb, nullptr, (unsigned char*)(p.ws + OFF_H8), (float*)wl(p, l, W_SK), xb); }
    if constexpr (PH == PH_PQ) { g8::EpiScoresT e{wsf(p, OFF_SC)}; g8::gemm_stream<DM, DM, false, g8::EpiScoresT, false>(wsb(p, OFF_H), 0, wl(p, l, W_Q), 0, g8::Order{MR / 256, 8, 1, nb, bid}, e, smem); }
    if constexpr (PH == PH_PSC) { peer_scores_phase(p, l, (MR / 256) * 16, bid, nb); }
    if constexpr (PH == PH_PTK) { for (int u = bid * 8 + (lid() >> 6); u < (MR / 64) * 8; u += nb * 8) peer_topk_task(p, u & 7, (u >> 3) * 64, smem); }
    if constexpr (PH == PH_PU) { peer_u_pass(p, l, MR, bid, nb); }
    if constexpr (PH == PH_PM) { peer_mid(p, l, MR, bid, nb); }
    if constexpr (PH == PH_PV) { peer_v_pass(p, l, MR, xb, last ? p.out : nullptr, bid, nb, commit, smem); }
}

constexpr int LDS_PVX = 131072 + 512;
constexpr int LDS_BYTES = 131072 + 512 + 8192;

#if !MK_ONE_LAUNCH
template <int PH>
__global__ void __launch_bounds__(512, 2) k_phase(P p, int l) {
    extern __shared__ __attribute__((aligned(16))) char smem[];
    lid_init();
    run_phase<PH>(p, l, smem, blockIdx.x, gridDim.x);
}
template <int PH> static void launch_phase(const P& p, int l, hipStream_t st) {
    static bool attr = false;
    if (!attr) { hipFuncSetAttribute((const void*)k_phase<PH>, hipFuncAttributeMaxDynamicSharedMemorySize, LDS_BYTES); attr = true; }
    hipLaunchKernelGGL(k_phase<PH>, dim3(256), dim3(512), LDS_BYTES, st, p, l);
}
#else
template <int PH> DEV void phase_and_barrier(const P& p, int l, char* smem, const XcdBarrier& bar, bool final_phase = false) {
    constexpr int NREP = (PH == PROBE_PH) ? PROBE_N : 1;
#pragma unroll 1
    for (int rep = 0; rep < NREP; ++rep) {
        run_phase<PH>(p, l, smem, blockIdx.x, gridDim.x, rep == NREP - 1);
        if (!(final_phase && rep == NREP - 1)) xcd_barrier(bar);
    }
}
__global__ void __launch_bounds__(512, 2) k_mega(P p) {
    extern __shared__ __attribute__((aligned(16))) char smem[];
    uint4* xbw = (uint4*)(smem + 131072);
    if (threadIdx.x == 0) *xbw = make_uint4(0u, 0u, 0u, 0u);
    lid_init();
    XcdBarrier bar = xcd_barrier_post((unsigned*)(p.ws + OFF_BAR), (volatile LAS unsigned*)xbw);
    phase_and_barrier<PH_PRO>(p, 0, smem, bar);
    for (int l = 0; l < 2; ++l) {
        phase_and_barrier<PH_NORM1>(p, l, smem, bar);
        phase_and_barrier<PH_PROJ>(p, l, smem, bar);
        phase_and_barrier<PH_PREP1>(p, l, smem, bar);
        phase_and_barrier<PH_UP>(p, l, smem, bar);
        phase_and_barrier<PH_PREP2>(p, l, smem, bar);
        phase_and_barrier<PH_MIX>(p, l, smem, bar);
        phase_and_barrier<PH_Z>(p, l, smem, bar);
        phase_and_barrier<PH_G>(p, l, smem, bar);
        phase_and_barrier<PH_O>(p, l, smem, bar);
        phase_and_barrier<PH_NORM2>(p, l, smem, bar);
        phase_and_barrier<PH_PQ>(p, l, smem, bar);
        phase_and_barrier<PH_PTK>(p, l, smem, bar);
        phase_and_barrier<PH_PU>(p, l, smem, bar);
        phase_and_barrier<PH_PM>(p, l, smem, bar);
        phase_and_barrier<PH_PV>(p, l, smem, bar, l == 1);
    }
}
#endif

extern "C" void kernel_launch(void* const* d_in, const int* in_sizes, int n_in, void* d_out, int out_size, void* d_ws, size_t ws_size, hipStream_t stream) {
    if (n_in != 29 || ws_size < WS_NEED) { fprintf(stderr, "kernel_launch: bad args n_in=%d ws=%zu need=%zu\n", n_in, ws_size, (size_t)WS_NEED); return; }
    P p{};
    const float** f = (const float**)&p;
    for (int i = 0; i < 29; ++i) f[i] = (const float*)d_in[i];
    p.out = (float*)d_out; p.ws = (char*)d_ws;
#if !MK_ONE_LAUNCH
    launch_phase<PH_PRO>(p, 0, stream);
    for (int l = 0; l < 2; ++l) {
        launch_phase<PH_NORM1>(p, l, stream); launch_phase<PH_PROJ>(p, l, stream); launch_phase<PH_PREP1>(p, l, stream); launch_phase<PH_UP>(p, l, stream);
        launch_phase<PH_PREP2>(p, l, stream); launch_phase<PH_MIX>(p, l, stream); launch_phase<PH_Z>(p, l, stream); launch_phase<PH_G>(p, l, stream);
        launch_phase<PH_O>(p, l, stream); launch_phase<PH_NORM2>(p, l, stream); launch_phase<PH_PQ>(p, l, stream);
        launch_phase<PH_PTK>(p, l, stream); launch_phase<PH_PU>(p, l, stream); launch_phase<PH_PM>(p, l, stream); launch_phase<PH_PV>(p, l, stream);
    }
#else
    static int grid = 0;
    if (!grid) {
        hipFuncSetAttribute((const void*)k_mega, hipFuncAttributeMaxDynamicSharedMemorySize, LDS_BYTES);
        int dev = 0, cus = 0, per_cu = 0; hipGetDevice(&dev); hipDeviceGetAttribute(&cus, hipDeviceAttributeMultiprocessorCount, dev);
        hipOccupancyMaxActiveBlocksPerMultiprocessor(&per_cu, (const void*)k_mega, 512, LDS_BYTES);
        grid = cus * (per_cu < 1 ? per_cu : 1);
        if (grid <= 0) { fprintf(stderr, "kernel_launch: occupancy query says %d blocks/CU\n", per_cu); grid = 0; return; }
    }
    hipMemsetAsync((char*)d_ws + OFF_BAR, 0, 16384, stream);
    hipLaunchKernelGGL(k_mega, dim3(grid), dim3(512), LDS_BYTES, stream, p);
#endif
    const hipError_t le = hipPeekAtLastError();
    if (le != hipSuccess) fprintf(stderr, "kernel_launch: launch failed: %s\n", hipGetErrorName(le));
}
```
